# Optimizing an MI355X kernel written in HIP

```python
import math
import jax, jax.numpy as jnp
from jax import lax
import numpy as np

D_MODEL = 4096
BATCH = 8
SEQ = 2048
DEPTH = 1

HEAD_DIM = 128
MOBA_HEADS = D_MODEL // (2 * HEAD_DIM)
DIFF_HEADS = D_MODEL // (4 * HEAD_DIM)
MOBA_WIDTH = MOBA_HEADS * HEAD_DIM
DIFF_QK_WIDTH = DIFF_HEADS * 2 * HEAD_DIM
DIFF_V_WIDTH = DIFF_HEADS * 2 * HEAD_DIM
MIX_WIDTH = MOBA_WIDTH + DIFF_V_WIDTH
IN_WIDTH = 3 * MOBA_WIDTH + 2 * DIFF_QK_WIDTH + DIFF_V_WIDTH
IN_SPLITS = (MOBA_WIDTH, 2 * MOBA_WIDTH, 3 * MOBA_WIDTH,
             3 * MOBA_WIDTH + DIFF_QK_WIDTH, 3 * MOBA_WIDTH + 2 * DIFF_QK_WIDTH)

MOBA_BLOCK = 256
MOBA_TOPK = 3
MOBA_Q_CHUNK = 8
DENSE_Q_BLOCK = 128
ROPE_THETA = 500000.0
ROT_DIM = HEAD_DIM // 4
MEM_LEN = 256
MEM_HEADS = 4
MEM_HEAD_DIM = 128
MEM_WIDTH = MEM_HEADS * MEM_HEAD_DIM
D_FF = -(-8 * D_MODEL // (3 * 256)) * 256
NORM_EPS = 1e-6

kernel_name = "hymba_moba_diffattn_hybrid_layer"


def rms_norm(x, g):
    xf = x.astype(jnp.float32)
    y = xf * lax.rsqrt(jnp.mean(xf * xf, axis=-1, keepdims=True) + NORM_EPS)
    return (y * g.astype(jnp.float32)).astype(x.dtype)


def rope_tables(seq):
    pos = jnp.arange(seq, dtype=jnp.float32)
    inv = ROPE_THETA ** (-jnp.arange(0, ROT_DIM, 2, dtype=jnp.float32) / ROT_DIM)
    ang = pos[:, None] * inv[None, :]
    return jnp.cos(ang), jnp.sin(ang)


def apply_partial_rope(x, cos, sin):
    half = ROT_DIM // 2
    x1 = x[..., :half].astype(jnp.float32)
    x2 = x[..., half:ROT_DIM].astype(jnp.float32)
    r1 = (x1 * cos - x2 * sin).astype(x.dtype)
    r2 = (x2 * cos + x1 * sin).astype(x.dtype)
    return jnp.concatenate([r1, r2, x[..., ROT_DIM:]], axis=-1)


def moba_attention(q, k, v):
    b, h, s, dh = q.shape
    nb = -(-s // MOBA_BLOCK)
    pad = nb * MOBA_BLOCK - s
    kp = jnp.pad(k, ((0, 0), (0, 0), (0, pad), (0, 0)))
    vp = jnp.pad(v, ((0, 0), (0, 0), (0, pad), (0, 0)))
    kb = kp.reshape(b, h, nb, MOBA_BLOCK, dh)
    vb = vp.reshape(b, h, nb, MOBA_BLOCK, dh)
    scale = dh ** -0.5
    n_sel = min(MOBA_TOPK, nb - 1)
    q_blk = jnp.arange(s) // MOBA_BLOCK
    if n_sel > 0:
        k_mean = jnp.mean(kb.astype(jnp.float32), axis=3)
        gate = jnp.einsum('bhsd,bhnd->bhsn', q.astype(jnp.float32), k_mean)
        past = jnp.arange(nb)[None, :] < q_blk[:, None]
        gate = jnp.where(past, gate, -jnp.inf)
        _, sel_idx = lax.top_k(gate, n_sel)
    bi = jnp.arange(b)[:, None, None, None]
    hi = jnp.arange(h)[None, :, None, None]
    C = MOBA_Q_CHUNK

    def chunk(c):
        start = c * C
        qc = lax.dynamic_slice_in_dim(q, start, C, axis=2)
        qpos = start + jnp.arange(C)
        own = start // MOBA_BLOCK
        k_own = lax.dynamic_index_in_dim(kb, own, axis=2, keepdims=False)
        v_own = lax.dynamic_index_in_dim(vb, own, axis=2, keepdims=False)
        kpos = own * MOBA_BLOCK + jnp.arange(MOBA_BLOCK)
        s_own = jnp.einsum('bhcd,bhnd->bhcn', qc, k_own).astype(jnp.float32) * scale
        s_own = jnp.where(kpos[None, :] <= qpos[:, None], s_own, -jnp.inf)
        if n_sel > 0:
            idx = lax.dynamic_slice_in_dim(sel_idx, start, C, axis=2)
            k_sel = kb[bi, hi, idx]
            v_sel = vb[bi, hi, idx]
            s_sel = jnp.einsum('bhcd,bhcjnd->bhcjn', qc, k_sel).astype(jnp.float32) * scale
            valid = idx < (qpos // MOBA_BLOCK)[None, None, :, None]
            s_sel = jnp.where(valid[..., None], s_sel, -jnp.inf)
            scores = jnp.concatenate(
                [s_sel.reshape(b, h, C, n_sel * MOBA_BLOCK), s_own], axis=-1)
            p = jax.nn.softmax(scores, axis=-1).astype(v.dtype)
            p_sel = p[..., :n_sel * MOBA_BLOCK].reshape(b, h, C, n_sel, MOBA_BLOCK)
            p_own = p[..., n_sel * MOBA_BLOCK:]
            return (jnp.einsum('bhcjn,bhcjnd->bhcd', p_sel, v_sel)
                    + jnp.einsum('bhcn,bhnd->bhcd', p_own, v_own))
        p_own = jax.nn.softmax(s_own, axis=-1).astype(v.dtype)
        return jnp.einsum('bhcn,bhnd->bhcd', p_own, v_own)

    outs = lax.map(chunk, jnp.arange(s // C))
    return outs.transpose(1, 2, 0, 3, 4).reshape(b, h, s, dh)


def diff_attention(q, k, v, lam, subln_g, lam_init):
    b, h, _, s, dh = q.shape
    scale = dh ** -0.5
    kpos = jnp.arange(s)
    QB = DENSE_Q_BLOCK

    def qblock(i):
        start = i * QB
        qb = lax.dynamic_slice_in_dim(q, start, QB, axis=3)
        sc = jnp.einsum('bhmqd,bhmkd->bhmqk', qb, k).astype(jnp.float32) * scale
        qpos = start + jnp.arange(QB)
        sc = jnp.where(kpos[None, :] <= qpos[:, None], sc, -jnp.inf)
        p = jax.nn.softmax(sc, axis=-1)
        w = p[:, :, 0] - lam * p[:, :, 1]
        return jnp.einsum('bhqk,bhke->bhqe', w.astype(v.dtype), v)

    o = lax.map(qblock, jnp.arange(s // QB))
    o = o.transpose(1, 2, 0, 3, 4).reshape(b, h, s, 2 * dh)
    return rms_norm(o, subln_g) * (1.0 - lam_init)


def memory_cross_attention(hn, mem_n, wq, wk, wv, wo, qn_g, kn_g):
    b, s, _ = hn.shape
    m = mem_n.shape[1]
    q = rms_norm((hn @ wq).reshape(b, s, MEM_HEADS, MEM_HEAD_DIM), qn_g)
    k = rms_norm((mem_n @ wk).reshape(b, m, MEM_HEADS, MEM_HEAD_DIM), kn_g)
    v = (mem_n @ wv).reshape(b, m, MEM_HEADS, MEM_HEAD_DIM)
    sc = jnp.einsum('bshd,bmhd->bhsm', q, k).astype(jnp.float32) * (MEM_HEAD_DIM ** -0.5)
    p = jax.nn.softmax(sc, axis=-1).astype(v.dtype)
    o = jnp.einsum('bhsm,bmhd->bshd', p, v).reshape(b, s, MEM_WIDTH)
    return o @ wo


def swiglu(hn, w_gate, w_up, w_down):
    return (jax.nn.silu(hn @ w_gate) * (hn @ w_up)) @ w_down


def setup_inputs(seed: int = 0) -> dict:
    key = jax.random.key(seed)
    ks = jax.random.split(key, 32)

    def nrm(k, shape, scale):
        return jax.random.normal(k, shape, jnp.float32) * scale

    def gain(k, shape):
        return 1.0 + 0.02 * jax.random.normal(k, shape, jnp.float32)

    L = DEPTH
    return {
        "x": nrm(ks[0], (BATCH, SEQ, D_MODEL), 1.0),
        "mem": nrm(ks[1], (BATCH, MEM_LEN, D_MODEL), 1.0),
        "norm_mix_g": gain(ks[2], (L, D_MODEL)),
        "w_in": nrm(ks[3], (L, D_MODEL, IN_WIDTH), D_MODEL ** -0.5),
        "q_norm_a": gain(ks[4], (L, HEAD_DIM)),
        "k_norm_a": gain(ks[5], (L, HEAD_DIM)),
        "q_norm_b": gain(ks[6], (L, HEAD_DIM)),
        "k_norm_b": gain(ks[7], (L, HEAD_DIM)),
        "lam_q1": nrm(ks[8], (L, HEAD_DIM), 0.1),
        "lam_k1": nrm(ks[9], (L, HEAD_DIM), 0.1),
        "lam_q2": nrm(ks[10], (L, HEAD_DIM), 0.1),
        "lam_k2": nrm(ks[11], (L, HEAD_DIM), 0.1),
        "diff_subln_g": gain(ks[12], (L, 2 * HEAD_DIM)),
        "w_out": nrm(ks[13], (L, MIX_WIDTH, D_MODEL), MIX_WIDTH ** -0.5),
        "norm_cross_g": gain(ks[14], (L, D_MODEL)),
        "norm_mem_g": gain(ks[15], (L, D_MODEL)),
        "w_mq": nrm(ks[16], (L, D_MODEL, MEM_WIDTH), D_MODEL ** -0.5),
        "w_mk": nrm(ks[17], (L, D_MODEL, MEM_WIDTH), D_MODEL ** -0.5),
        "w_mv": nrm(ks[18], (L, D_MODEL, MEM_WIDTH), D_MODEL ** -0.5),
        "w_mo": nrm(ks[19], (L, MEM_WIDTH, D_MODEL), MEM_WIDTH ** -0.5),
        "q_norm_m": gain(ks[20], (L, MEM_HEAD_DIM)),
        "k_norm_m": gain(ks[21], (L, MEM_HEAD_DIM)),
        "norm_ffn_g": gain(ks[22], (L, D_MODEL)),
        "w_gate": nrm(ks[23], (L, D_MODEL, D_FF), D_MODEL ** -0.5),
        "w_up": nrm(ks[24], (L, D_MODEL, D_FF), D_MODEL ** -0.5),
        "w_down": nrm(ks[25], (L, D_FF, D_MODEL), D_FF ** -0.5),
    }


def reference(x, mem, norm_mix_g, w_in, q_norm_a, k_norm_a, q_norm_b, k_norm_b,
              lam_q1, lam_k1, lam_q2, lam_k2, diff_subln_g, w_out,
              norm_cross_g, norm_mem_g, w_mq, w_mk, w_mv, w_mo, q_norm_m, k_norm_m,
              norm_ffn_g, w_gate, w_up, w_down):
    b, s, _ = x.shape
    cos, sin = rope_tables(s)
    h = x
    for l in range(DEPTH):
        lam_init = 0.8 - 0.6 * math.exp(-0.3 * l)
        xn = rms_norm(h, norm_mix_g[l])
        proj = xn @ w_in[l]
        qa, ka, va, qb, kb, vb = jnp.split(proj, IN_SPLITS, axis=-1)
        qa = qa.reshape(b, s, MOBA_HEADS, HEAD_DIM).transpose(0, 2, 1, 3)
        ka = ka.reshape(b, s, MOBA_HEADS, HEAD_DIM).transpose(0, 2, 1, 3)
        va = va.reshape(b, s, MOBA_HEADS, HEAD_DIM).transpose(0, 2, 1, 3)
        qa = apply_partial_rope(rms_norm(qa, q_norm_a[l]), cos, sin)
        ka = apply_partial_rope(rms_norm(ka, k_norm_a[l]), cos, sin)
        out_a = moba_attention(qa, ka, va)
        out_a = out_a.transpose(0, 2, 1, 3).reshape(b, s, MOBA_WIDTH)

        qb = qb.reshape(b, s, DIFF_HEADS, 2, HEAD_DIM).transpose(0, 2, 3, 1, 4)
        kb = kb.reshape(b, s, DIFF_HEADS, 2, HEAD_DIM).transpose(0, 2, 3, 1, 4)
        vb = vb.reshape(b, s, DIFF_HEADS, 2 * HEAD_DIM).transpose(0, 2, 1, 3)
        qb = apply_partial_rope(rms_norm(qb, q_norm_b[l]), cos, sin)
        kb = apply_partial_rope(rms_norm(kb, k_norm_b[l]), cos, sin)
        lam = (jnp.exp(jnp.sum(lam_q1[l].astype(jnp.float32) * lam_k1[l].astype(jnp.float32)))
               - jnp.exp(jnp.sum(lam_q2[l].astype(jnp.float32) * lam_k2[l].astype(jnp.float32)))
               + lam_init)
        out_b = diff_attention(qb, kb, vb, lam, diff_subln_g[l], lam_init)
        out_b = out_b.transpose(0, 2, 1, 3).reshape(b, s, DIFF_V_WIDTH)

        h = h + jnp.concatenate([out_a, out_b], axis=-1) @ w_out[l]
        hn = rms_norm(h, norm_cross_g[l])
        mem_n = rms_norm(mem, norm_mem_g[l])
        h = h + memory_cross_attention(hn, mem_n, w_mq[l], w_mk[l], w_mv[l], w_mo[l],
                                       q_norm_m[l], k_norm_m[l])
        h = h + swiglu(rms_norm(h, norm_ffn_g[l]), w_gate[l], w_up[l], w_down[l])
    return h
```

```cpp
#include <hip/hip_runtime.h>
#include <cstdio>
#include <cstdint>
namespace pg8 {
#define PG8_LAS __attribute__((address_space(3)))
typedef unsigned short bf16_t;
typedef short bf16x8 __attribute__((ext_vector_type(8)));
typedef float f32x4 __attribute__((ext_vector_type(4)));
typedef unsigned u32x4 __attribute__((ext_vector_type(4)));
constexpr int BM = 256, BK = 64, HALF = 128, HTB = HALF * BK * 2  , STAGE_BYTES = 8 * HTB, NXCD = 8, WGM = 8;

__host__ __device__ __forceinline__ int lds_byte(int r, int c) { const int st = (r >> 4) * 2 + (c >> 5), rr = r & 15, cc = c & 31, ob = rr * 64 + cc * 2; return st * 1024 + (ob ^ (((ob >> 9) & 1) << 5)); }
__host__ __device__ __forceinline__ void stage_rc(int b, int& R, int& C) { const int st = b / 1024, sb = b % 1024, swz = sb ^ (((sb >> 9) & 1) << 5); R = (st >> 1) * 16 + swz / 64; C = (st & 1) * 32 + (swz % 64) / 2; }
__host__ __device__ __forceinline__ int perm32(int rho) { const int n = rho >> 4, i = rho & 15; return 8 * (i >> 2) + 4 * n + (i & 3); }

struct Unit { int pm, pn; };
struct Gemm { const bf16_t* A; const bf16_t* Bt; int M, N, K; };

struct StaticOrder {
    int nM, nN, nwg, G, c;
    __host__ __device__ void init(int M, int N, int G_, int c_) { nM = M / BM; nN = N / BM; nwg = nM * nN; G = G_; c = c_; }
    __host__ __device__ bool next(int i, Unit& u) const {
        const long L = (long)i * G + c; if (L >= nwg) return false;
        int wgid = (int)L; { const int q = nwg / NXCD, r = nwg % NXCD, xcd = wgid % NXCD, off = wgid / NXCD; wgid = (xcd < r ? xcd * (q + 1) : r * (q + 1) + (xcd - r) * q) + off; }
        const int nig = WGM * nN, gid = wgid / nig, fm = gid * WGM, gsz = (nM - fm) < WGM ? (nM - fm) : WGM;
        u.pm = fm + ((wgid % nig) % gsz); u.pn = (wgid % nig) / gsz; return true;
    }
    __device__ __forceinline__ void a_ready(const Unit&) const {}
    __device__ __forceinline__ void done(const Unit&) const {}
};

__device__ __forceinline__ unsigned cvt_pk_bf16(float lo, float hi) { unsigned r; asm volatile("v_cvt_pk_bf16_f32 %0, %1, %2" : "=v"(r) : "v"(lo), "v"(hi)); return r; }
typedef float f32x2 __attribute__((ext_vector_type(2)));
__device__ __forceinline__ f32x2 gelu_pk(f32x2 v) {
    const f32x2 av = __builtin_elementwise_abs(v), d = av * 0.2316418882f + 1.0f;
    f32x2 t; t.x = __builtin_amdgcn_rcpf(d.x); t.y = __builtin_amdgcn_rcpf(d.y);
    f32x2 q = t * 0.5307027145f + (-0.7265760135f); q = q * t + 0.7107068705f; q = q * t + (-0.142248368f); q = q * t + 0.127414796f; q = q * t;
    const f32x2 s = (v * v) * (-0.72134752044f);
    f32x2 e; e.x = __builtin_amdgcn_exp2f(s.x); e.y = __builtin_amdgcn_exp2f(s.y);
    const f32x2 m = v * (q * e), r = v - m;
    f32x2 o; o.x = v.x < 0.f ? m.x : r.x; o.y = v.y < 0.f ? m.y : r.y; return o;
}

template <int ACT  > struct EpiBf16 {
    static constexpr bool PERM = true, AFTER_DRAIN = false; static_assert(ACT == 0 || ACT == 1, "EpiBf16: ACT is 0 (none) or 1 (gelu_pk)");
    bf16_t* O; int ldc; const float* bias; int split_cols; size_t split_stride; float scale0;
    __device__ __forceinline__ void operator()(const f32x4 (&acc)[2][2][4][2], const Unit& u, int wr, int wc, int fr, int fq) const {
        const int row0 = u.pm * BM + wr * 64 + fr; int colt = u.pn * BM; bf16_t* base = O;
        float sc = 1.f; if (split_cols) { const int t = colt / split_cols; base += (size_t)t * split_stride; colt -= t * split_cols; if (t == 0) sc = scale0; }
        const int col0 = colt + wc * 32 + 8 * fq, bcol0 = u.pn * BM + wc * 32 + 8 * fq;
        f32x4 bv[2][2];
#pragma unroll
        for (int bj = 0; bj < 2; ++bj)
#pragma unroll
            for (int n = 0; n < 2; ++n) bv[bj][n] = bias ? *(const f32x4*)(bias + bcol0 + bj * HALF + 4 * n) : (f32x4){0.f, 0.f, 0.f, 0.f};
#pragma unroll
        for (int ai = 0; ai < 2; ++ai)
#pragma unroll
            for (int m = 0; m < 4; ++m) { bf16_t* rowp = base + (size_t)(row0 + ai * HALF + m * 16) * ldc + col0;
#pragma unroll
                for (int bj = 0; bj < 2; ++bj) { f32x4 v0 = acc[ai][bj][m][0] + bv[bj][0], v1 = acc[ai][bj][m][1] + bv[bj][1];
                    if (ACT == 1) { f32x2 a = gelu_pk((f32x2){v0[0], v0[1]}), b = gelu_pk((f32x2){v0[2], v0[3]}), c = gelu_pk((f32x2){v1[0], v1[1]}), d = gelu_pk((f32x2){v1[2], v1[3]});
                        v0 = (f32x4){a.x, a.y, b.x, b.y}; v1 = (f32x4){c.x, c.y, d.x, d.y}; }
                    v0 = v0 * sc; v1 = v1 * sc; u32x4 w; w.x = cvt_pk_bf16(v0[0], v0[1]); w.y = cvt_pk_bf16(v0[2], v0[3]); w.z = cvt_pk_bf16(v1[0], v1[1]); w.w = cvt_pk_bf16(v1[2], v1[3]);
                    *(u32x4*)(rowp + bj * HALF) = w; } }
    }
};


struct EpiResF32 {
    static constexpr bool PERM = false, AFTER_DRAIN = false;
    const float* base; float* out; int ldc;
    __device__ __forceinline__ void operator()(const f32x4 (&acc)[2][2][4][2], const Unit& u, int wr, int wc, int fr, int fq) const {
        const int row0 = u.pm * BM + wr * 64 + fr, col0 = u.pn * BM + wc * 32 + 4 * fq;
#pragma unroll
        for (int ai = 0; ai < 2; ++ai)
#pragma unroll
            for (int m = 0; m < 4; ++m) { const size_t off = (size_t)(row0 + ai * HALF + m * 16) * ldc + col0;
                f32x4 b[2][2];
#pragma unroll
                for (int bj = 0; bj < 2; ++bj)
#pragma unroll
                    for (int n = 0; n < 2; ++n) b[bj][n] = *(const f32x4*)(base + off + bj * HALF + n * 16);
#pragma unroll
                for (int bj = 0; bj < 2; ++bj)
#pragma unroll
                    for (int n = 0; n < 2; ++n) *(f32x4*)(out + off + bj * HALF + n * 16) = b[bj][n] + acc[ai][bj][m][n];
                if (m & 1) asm volatile("" ::: "memory"); }
    }
};
struct EpiSwiGLU {
    static constexpr bool PERM = true, AFTER_DRAIN = false;
    bf16_t* H; int ldh;
    __device__ __forceinline__ void operator()(const f32x4 (&acc)[2][2][4][2], const Unit& u, int wr, int wc, int fr, int fq) const {
        const int row0 = u.pm * BM + wr * 64 + fr, col0 = u.pn * HALF + wc * 32 + 8 * fq;
#pragma unroll
        for (int ai = 0; ai < 2; ++ai)
#pragma unroll
            for (int m = 0; m < 4; ++m) { bf16_t* rowp = H + (size_t)(row0 + ai * HALF + m * 16) * ldh + col0;
                float h[8];
#pragma unroll
                for (int n = 0; n < 2; ++n)
#pragma unroll
                    for (int e = 0; e < 4; ++e) { const float g = acc[ai][0][m][n][e], up = acc[ai][1][m][n][e];
                        const float sg = __builtin_amdgcn_rcpf(1.0f + __builtin_amdgcn_exp2f(g * -1.4426950408889634f));
                        h[n * 4 + e] = g * sg * up; }
                u32x4 w; w.x = cvt_pk_bf16(h[0], h[1]); w.y = cvt_pk_bf16(h[2], h[3]); w.z = cvt_pk_bf16(h[4], h[5]); w.w = cvt_pk_bf16(h[6], h[7]);
                *(u32x4*)rowp = w; }
    }
};

template <class Epi, class Sched, bool ALIGN_EPI = false, bool SP2 = false>
__device__ __forceinline__ void gemm_phase(PG8_LAS unsigned char* lds, const Gemm g, const Sched& S, const Epi& E) {
    const int tid = threadIdx.x, wid = __builtin_amdgcn_readfirstlane(tid >> 6), lane = tid & 63, wr = wid >> 2, wc = wid & 3, fr = lane & 15, fq = lane >> 4;
    const int K = g.K, nt = K / BK;
    unsigned voffA[2], voffB[2];
#pragma unroll
    for (int i = 0; i < 2; ++i) { int R, C; stage_rc(tid * 16 + i * 8192, R, C); const int Rb = Epi::PERM ? ((R & ~31) + perm32(R & 31)) : R;
        voffA[i] = (unsigned)(R * K + C) * 2u; voffB[i] = (unsigned)(Rb * K + C) * 2u; }
    const size_t kstep = (size_t)(BK * 2);
    const size_t hstep = (size_t)HALF * K * 2;
    const size_t tstep = 2 * hstep;
    const unsigned ldsw = (unsigned)wid * 1024u;
    const int aoff = lds_byte(wr * 64 + fr, fq * 8), boff = lds_byte(wc * 32 + fr, fq * 8);
#define PG8_SA(b, h) (((b) * 2 + (h)) * HTB)
#define PG8_SB(b, h) ((4 + (b) * 2 + (h)) * HTB)
#define PG8_STAGE(bufoff, gbase, voff) do { _Pragma("unroll") for (int _i = 0; _i < 2; ++_i) \
        __builtin_amdgcn_global_load_lds((const unsigned*)((const char*)(gbase) + (voff)[_i]), (PG8_LAS unsigned*)(lds + (bufoff) + ldsw + _i * 8192), 16, 0, 0); } while (0)
#define PG8_LDA(dst, b, h) do { _Pragma("unroll") for (int m = 0; m < 4; ++m) _Pragma("unroll") for (int k = 0; k < 2; ++k) dst[m][k] = *(const PG8_LAS bf16x8*)(lds + PG8_SA(b, h) + aoff + m * 2048 + k * 1024); } while (0)
#define PG8_LDB(dst, b, h) do { _Pragma("unroll") for (int n = 0; n < 2; ++n) _Pragma("unroll") for (int k = 0; k < 2; ++k) dst[n][k] = *(const PG8_LAS bf16x8*)(lds + PG8_SB(b, h) + boff + n * 2048 + k * 1024); } while (0)
#define PG8_MMA(ai, bj, At, Bt) do { __builtin_amdgcn_s_setprio(1); _Pragma("unroll") for (int m = 0; m < 4; ++m) _Pragma("unroll") for (int n = 0; n < 2; ++n) _Pragma("unroll") for (int k = 0; k < 2; ++k) \
        acc[ai][bj][m][n] = __builtin_amdgcn_mfma_f32_16x16x32_bf16(Bt[n][k], At[m][k], acc[ai][bj][m][n], 0, 0, 0); __builtin_amdgcn_s_setprio(0); } while (0)
#define PG8_WAIT_V(n) asm volatile("s_waitcnt vmcnt(" #n ")" ::: "memory")
#define PG8_WAIT_L(n) asm volatile("s_waitcnt lgkmcnt(" #n ")" ::: "memory")
#define PG8_BAR __builtin_amdgcn_s_barrier()
#define PG8_SCHED __builtin_amdgcn_sched_barrier(0)
    Unit cur, nxt; int ui = 0;
    if (!S.next(0, cur)) return;
    f32x4 acc[2][2][4][2];
#pragma unroll
    for (int a = 0; a < 2; ++a)
#pragma unroll
        for (int b = 0; b < 2; ++b)
#pragma unroll
            for (int m = 0; m < 4; ++m)
#pragma unroll
                for (int n = 0; n < 2; ++n) acc[a][b][m][n] = (f32x4){0.f, 0.f, 0.f, 0.f};
    bf16x8 At[4][2], B0[2][2], B1[2][2];
    const char* cA = (const char*)g.A + (size_t)cur.pm * tstep; const char* cB = (const char*)g.Bt + (size_t)cur.pn * tstep;
    S.a_ready(cur);
    if constexpr (SP2) {
        PG8_STAGE(PG8_SB(0, 0), cB, voffB); PG8_STAGE(PG8_SB(0, 1), cB + hstep, voffB); PG8_STAGE(PG8_SA(0, 0), cA, voffA); PG8_STAGE(PG8_SA(0, 1), cA + hstep, voffA);
        if (wr == 1) PG8_BAR;
        PG8_WAIT_V(2); PG8_BAR;
        PG8_STAGE(PG8_SB(1, 0), cB + kstep, voffB); PG8_STAGE(PG8_SA(1, 0), cA + kstep, voffA); PG8_STAGE(PG8_SB(1, 1), cB + hstep + kstep, voffB);
        PG8_WAIT_V(6); PG8_BAR;
    } else {
        PG8_STAGE(PG8_SB(0, 0), cB, voffB); PG8_STAGE(PG8_SA(0, 0), cA, voffA); PG8_STAGE(PG8_SB(0, 1), cB + hstep, voffB); PG8_STAGE(PG8_SA(0, 1), cA + hstep, voffA);
        if (wr == 1) PG8_BAR;
        PG8_WAIT_V(4); PG8_BAR;
        PG8_STAGE(PG8_SB(1, 0), cB + kstep, voffB); PG8_STAGE(PG8_SA(1, 0), cA + kstep, voffA); PG8_STAGE(PG8_SB(1, 1), cB + hstep + kstep, voffB);
        PG8_WAIT_V(6); PG8_BAR;
    }
    for (;;) {
        const bool has_next = S.next(ui + 1, nxt);
        const char* nA = has_next ? (const char*)g.A + (size_t)nxt.pm * tstep : cA; const char* nB = has_next ? (const char*)g.Bt + (size_t)nxt.pn * tstep : cB;
        for (int t = 0; t < nt; t += 2) {
            const bool last = (t == nt - 2);
            const char* a1 = cA + (size_t)(t + 1) * kstep;
            const char* a2 = last ? nA : cA + (size_t)(t + 2) * kstep; const char* b2 = last ? nB : cB + (size_t)(t + 2) * kstep;
            const char* a3 = a2 + kstep; const char* b3 = b2 + kstep;
            if (last && has_next) S.a_ready(nxt);
            if constexpr (SP2) {
            PG8_LDB(B0, 0, 0); PG8_LDB(B1, 0, 1); PG8_SCHED; PG8_LDA(At, 0, 0); PG8_STAGE(PG8_SA(1, 1), a1 + hstep, voffA);
            PG8_WAIT_V(8); PG8_WAIT_L(0); PG8_BAR; PG8_MMA(0, 0, At, B0); PG8_MMA(0, 1, At, B1); PG8_BAR; PG8_SCHED;
            PG8_LDA(At, 0, 1); PG8_STAGE(PG8_SB(0, 0), b2, voffB); PG8_STAGE(PG8_SB(0, 1), b2 + hstep, voffB); PG8_STAGE(PG8_SA(0, 0), a2, voffA);
            PG8_WAIT_V(8); PG8_WAIT_L(0); PG8_BAR; PG8_MMA(1, 0, At, B0); PG8_MMA(1, 1, At, B1); PG8_BAR; PG8_SCHED;
            PG8_LDB(B0, 1, 0); PG8_LDB(B1, 1, 1); PG8_SCHED; PG8_LDA(At, 1, 0); PG8_STAGE(PG8_SA(0, 1), a2 + hstep, voffA);
            PG8_WAIT_V(8); PG8_WAIT_L(0); PG8_BAR; PG8_MMA(0, 0, At, B0); PG8_MMA(0, 1, At, B1); PG8_BAR; PG8_SCHED;
            PG8_LDA(At, 1, 1); PG8_STAGE(PG8_SB(1, 0), b3, voffB); PG8_STAGE(PG8_SB(1, 1), b3 + hstep, voffB); PG8_STAGE(PG8_SA(1, 0), a3, voffA);
            PG8_WAIT_V(8); PG8_WAIT_L(0); PG8_BAR; PG8_MMA(1, 0, At, B0); PG8_MMA(1, 1, At, B1); PG8_BAR; PG8_SCHED;
            } else {
            PG8_LDB(B0, 0, 0); PG8_SCHED; PG8_LDA(At, 0, 0); PG8_STAGE(PG8_SA(1, 1), a1 + hstep, voffA);
            PG8_WAIT_L(8); PG8_BAR; PG8_WAIT_L(0); PG8_MMA(0, 0, At, B0); PG8_BAR; PG8_SCHED;
            PG8_LDB(B1, 0, 1); PG8_STAGE(PG8_SB(0, 0), b2, voffB);
            PG8_BAR; PG8_WAIT_L(0); PG8_MMA(0, 1, At, B1); PG8_BAR;
            PG8_LDA(At, 0, 1); PG8_STAGE(PG8_SA(0, 0), a2, voffA);
            PG8_BAR; PG8_WAIT_L(0); PG8_MMA(1, 0, At, B0); PG8_BAR; PG8_SCHED;
            PG8_STAGE(PG8_SB(0, 1), b2 + hstep, voffB);
            PG8_WAIT_V(6); PG8_BAR; PG8_MMA(1, 1, At, B1); PG8_BAR;
            PG8_LDB(B0, 1, 0); PG8_SCHED; PG8_LDA(At, 1, 0); PG8_STAGE(PG8_SA(0, 1), a2 + hstep, voffA);
            PG8_WAIT_L(8); PG8_BAR; PG8_WAIT_L(0); PG8_MMA(0, 0, At, B0); PG8_BAR; PG8_SCHED;
            PG8_LDB(B1, 1, 1); PG8_STAGE(PG8_SB(1, 0), b3, voffB);
            PG8_BAR; PG8_WAIT_L(0); PG8_MMA(0, 1, At, B1); PG8_BAR;
            PG8_LDA(At, 1, 1); PG8_STAGE(PG8_SA(1, 0), a3, voffA);
            PG8_BAR; PG8_WAIT_L(0); PG8_MMA(1, 0, At, B0); PG8_BAR; PG8_SCHED;
            PG8_STAGE(PG8_SB(1, 1), b3 + hstep, voffB);
            PG8_WAIT_V(6); PG8_BAR; PG8_MMA(1, 1, At, B1); PG8_BAR;
            }
        }
        if constexpr (ALIGN_EPI) { if (wr == 0) PG8_BAR; }
        if constexpr (!Epi::AFTER_DRAIN) { E(acc, cur, wr, wc, fr, fq); S.done(cur); }
        if (!has_next) break;
#pragma unroll
        for (int a = 0; a < 2; ++a)
#pragma unroll
            for (int b = 0; b < 2; ++b)
#pragma unroll
                for (int m = 0; m < 4; ++m)
#pragma unroll
                    for (int n = 0; n < 2; ++n) acc[a][b][m][n] = (f32x4){0.f, 0.f, 0.f, 0.f};
        cur = nxt; cA = nA; cB = nB; ++ui;
        if constexpr (ALIGN_EPI) { if (wr == 1) PG8_BAR; }
    }
    PG8_WAIT_V(0);
    if constexpr (!ALIGN_EPI) { if (wr == 0) PG8_BAR; }
    PG8_BAR;
    if constexpr (Epi::AFTER_DRAIN) { E.fused(acc, cur, wr, wc, fr, fq, lds, wid, lane); S.done(cur); }
#undef PG8_SA
#undef PG8_SB
#undef PG8_STAGE
#undef PG8_LDA
#undef PG8_LDB
#undef PG8_MMA
#undef PG8_WAIT_V
#undef PG8_WAIT_L
#undef PG8_BAR
#undef PG8_SCHED
}
}

#ifndef PG8_SP2
#define PG8_SP2 true
#endif
#ifndef PG8_ALIGN
#define PG8_ALIGN true
#endif


namespace att {
typedef unsigned short bf16;
typedef short bf16x8 __attribute__((ext_vector_type(8)));
typedef short s16x4 __attribute__((ext_vector_type(4)));
typedef float f32x16 __attribute__((ext_vector_type(16)));
typedef float f32x4 __attribute__((ext_vector_type(4)));
typedef unsigned u32x4 __attribute__((ext_vector_type(4)));
constexpr int NW = 8, QBLK = 32, KVBLK = 64, QB = NW * QBLK, D = 128;
constexpr float SCALE = 0.08838834764831845f;
constexpr float THR = 8.f;
constexpr int SHM_V = KVBLK * D * 2, SHM_K = KVBLK * D * 2;
constexpr int LDS_WS_OFF = 2 * SHM_V + 2 * SHM_K, LDS_KM_OFF = LDS_WS_OFF + NW * 64 * 4, LDS_BYTES = LDS_KM_OFF + 4096;
constexpr unsigned WBIG = 0x40000000u;

#define KSWZ(row, colB) ((row) * 256 + ((colB) ^ (((row) & 7) << 4)))
#define SBAR() __builtin_amdgcn_sched_barrier(0)
__device__ __forceinline__ int v_st(int k, int c) { const int kk = (k & ~0xC) | ((k & 4) << 1) | ((k & 8) >> 1); return ((kk >> 3) * 4 + (c >> 5)) * 512 + ((kk & 7) * 32 + (c & 31)) * 2; }
__device__ __forceinline__ int v_rd_base(int lane) { return ((lane & 3) << 3) | (((lane >> 2) & 3) << 6) | (((lane >> 4) & 1) << 5) | (((lane >> 5) & 1) << 8); }
constexpr int v_rd_off(int d0, int ks, int half) { return d0 * 512 + ks * 4096 + half * 2048; }
__device__ __forceinline__ int crow(int r, int hi) { return (r & 3) + 8 * (r >> 2) + 4 * hi; }
__device__ __forceinline__ unsigned cvtpk(float lo, float hi) { unsigned r; asm volatile("v_cvt_pk_bf16_f32 %0, %1, %2" : "=v"(r) : "v"(lo), "v"(hi)); return r; }
__device__ __forceinline__ bf16x8 load8(const bf16* p) { return *reinterpret_cast<const bf16x8*>(p); }
__device__ __forceinline__ void mask_tile(f32x16& p0, f32x16& p1, int dq, unsigned W) {
    const float NEG = -__builtin_inff();
#pragma unroll
    for (int r = 0; r < 16; ++r) {
        const int c = (r & 3) + 8 * (r >> 2);
        if ((unsigned)(dq - c) >= W) p0[r] = NEG;
        if ((unsigned)(dq - c - 32) >= W) p1[r] = NEG;
    }
}
__device__ __forceinline__ void partialSM(f32x16& p0, f32x16& p1, float& m_reg, float& mn, float& alpha) {
    float pmax = p0[0]; for (int r = 1; r < 16; ++r) pmax = fmaxf(pmax, p0[r]); for (int r = 0; r < 16; ++r) pmax = fmaxf(pmax, p1[r]);
    { auto rr = __builtin_amdgcn_permlane32_swap(__float_as_uint(pmax), __float_as_uint(pmax), false, false);
      pmax = fmaxf(__uint_as_float(rr[0]), __uint_as_float(rr[1])); }
    constexpr float C2 = 1.4426950408889634f * SCALE;
    if (__builtin_expect(__all((pmax - m_reg) * SCALE <= THR), 1)) { mn = m_reg; alpha = 1.f; }
    else { mn = fmaxf(m_reg, pmax); alpha = __builtin_amdgcn_exp2f((m_reg - mn) * C2); m_reg = mn; }
    const float mnL = -mn * C2;
    for (int r = 0; r < 16; ++r) p0[r] = fmaf(p0[r], C2, mnL); for (int r = 0; r < 16; ++r) p1[r] = fmaf(p1[r], C2, mnL);
    for (int r = 0; r < 16; ++r) p0[r] = __builtin_amdgcn_exp2f(p0[r]);
}
__device__ __forceinline__ void finishSM(f32x16& p0, f32x16& p1, float alpha, float& l_reg, bf16x8& pa0, bf16x8& pa1, bf16x8& pa2, bf16x8& pa3) {
    for (int r = 0; r < 16; ++r) p1[r] = __builtin_amdgcn_exp2f(p1[r]);
    float ps = 0; for (int r = 0; r < 16; ++r) ps += p0[r]; for (int r = 0; r < 16; ++r) ps += p1[r];
    { auto rr = __builtin_amdgcn_permlane32_swap(__float_as_uint(ps), __float_as_uint(ps), false, false);
      ps = __uint_as_float(rr[0]) + __uint_as_float(rr[1]); }
    l_reg = l_reg * alpha + ps;
#define PK4(P, B_, OUT) do { unsigned a0 = cvtpk(P[B_+0], P[B_+1]), a1 = cvtpk(P[B_+2], P[B_+3]);                          \
        unsigned b0 = cvtpk(P[B_+4], P[B_+5]), b1 = cvtpk(P[B_+6], P[B_+7]);                                             \
        auto r0 = __builtin_amdgcn_permlane32_swap(a0, b0, false, false); auto r1 = __builtin_amdgcn_permlane32_swap(a1, b1, false, false); \
        u32x4 w = {r0[0], r1[0], r0[1], r1[1]}; OUT = *reinterpret_cast<bf16x8*>(&w); } while (0)
    PK4(p0, 0, pa0); PK4(p0, 8, pa1); PK4(p1, 0, pa2); PK4(p1, 8, pa3);
#undef PK4
}
template <int KB>
__device__ __forceinline__ void qkt(f32x16& p0, f32x16& p1, const char* K_lds, int r32, int hi, const bf16x8* qr) {
    p0 = f32x16{}; p1 = f32x16{};
    const char* kb[4];
#pragma unroll
    for (int dd = 0; dd < 4; ++dd) kb[dd] = K_lds + KB * SHM_K + KSWZ(r32, (dd * 16 + hi * 8) * 2);
#pragma unroll
    for (int d0 = 0; d0 < 8; ++d0) { const char* a = kb[d0 & 3] + (d0 >> 2) * 128;
        bf16x8 b0 = *reinterpret_cast<const bf16x8*>(a);
        bf16x8 b1 = *reinterpret_cast<const bf16x8*>(a + 32 * 256);
        p0 = __builtin_amdgcn_mfma_f32_32x32x16_bf16(b0, qr[d0], p0, 0, 0, 0);
        p1 = __builtin_amdgcn_mfma_f32_32x32x16_bf16(b1, qr[d0], p1, 0, 0, 0); }
}
template <int VB>
__device__ __forceinline__ void pv_tile(f32x16* o, int vb0, bf16x8 pa0, bf16x8 pa1, bf16x8 pa2, bf16x8 pa3) {
#define TRRD(dst, off) asm volatile("ds_read_b64_tr_b16 %0, %1 offset:%2" : "=&v"(dst) : "v"(vb0), "i"(off) : "memory")
#define PV_D0(d0) do { s16x4 l0, l1, l2, l3, h0, h1, h2, h3; constexpr int b_ = VB * SHM_V + v_rd_off(d0, 0, 0);     \
        TRRD(l0, b_); TRRD(h0, b_ + 2048); TRRD(l1, b_ + 4096); TRRD(h1, b_ + 6144); TRRD(l2, b_ + 8192); TRRD(h2, b_ + 10240); TRRD(l3, b_ + 12288); TRRD(h3, b_ + 14336); \
        asm volatile("s_waitcnt lgkmcnt(0)" ::: "memory"); SBAR();                                                                                  \
        o[d0] = __builtin_amdgcn_mfma_f32_32x32x16_bf16(pa0, (bf16x8){l0[0], l0[1], l0[2], l0[3], h0[0], h0[1], h0[2], h0[3]}, o[d0], 0, 0, 0);   \
        o[d0] = __builtin_amdgcn_mfma_f32_32x32x16_bf16(pa1, (bf16x8){l1[0], l1[1], l1[2], l1[3], h1[0], h1[1], h1[2], h1[3]}, o[d0], 0, 0, 0);   \
        o[d0] = __builtin_amdgcn_mfma_f32_32x32x16_bf16(pa2, (bf16x8){l2[0], l2[1], l2[2], l2[3], h2[0], h2[1], h2[2], h2[3]}, o[d0], 0, 0, 0);   \
        o[d0] = __builtin_amdgcn_mfma_f32_32x32x16_bf16(pa3, (bf16x8){l3[0], l3[1], l3[2], l3[3], h3[0], h3[1], h3[2], h3[3]}, o[d0], 0, 0, 0); } while (0)
    PV_D0(0); PV_D0(1); PV_D0(2); PV_D0(3);
#undef PV_D0
#undef TRRD
}

struct BlockRef { const bf16* Q; const bf16* K; const bf16* V; bf16* O; const float* KM; int P0, skv, moba_qb; };
struct Seam { bf16x8 qr[8]; bf16x8 st_v0, st_v1, st_k0, st_k1; };
#define ROWP(p, k0, rr) ((p) + (size_t)((k0) + (rr)) * PKV + sc)
#define VMW() asm volatile("s_waitcnt vmcnt(0)" ::: "memory")
#define VMWN(n) asm volatile("s_waitcnt vmcnt(%0)" :: "i"(n) : "memory")
#define SLOAD_H(Kp, Vp, k0) do { S.st_v0 = load8(ROWP(Vp, k0, sr)); S.st_v1 = load8(ROWP(Vp, k0, 32 + sr));              \
                                 S.st_k0 = load8(ROWP(Kp, k0, sr)); S.st_k1 = load8(ROWP(Kp, k0, 32 + sr)); } while (0)
#define SWRITE_HK(bf) do { *(bf16x8*)(K_lds + (bf) * SHM_K + kws) = S.st_k0; *(bf16x8*)(K_lds + (bf) * SHM_K + kws + 32 * 256) = S.st_k1; } while (0)
#define SWRITE_HV(bf) do { *(bf16x8*)(V_lds + (bf) * SHM_V + vst0) = S.st_v0; *(bf16x8*)(V_lds + (bf) * SHM_V + vst1) = S.st_v1; } while (0)
#define SWRITE_H(bf) do { SWRITE_HV(bf); SWRITE_HK(bf); } while (0)
template <int PQ, int PKV, int PO, bool MOBA>
__device__ __forceinline__ void attn_prime(const BlockRef& cur, char* lds, Seam& S) {
    const int tid = threadIdx.x, wid = __builtin_amdgcn_readfirstlane(tid >> 6), lane = tid & 63, r32 = lane & 31, hi = lane >> 5;
    const int sr = tid >> 4, sc = (tid & 15) * 8, kws = KSWZ(sr, sc * 2); char* K_lds = lds + 2 * SHM_V;
    for (int d0 = 0; d0 < 8; ++d0) S.qr[d0] = load8(cur.Q + (size_t)(wid * QBLK + r32) * PQ + d0 * 16 + hi * 8);
    SLOAD_H(cur.K, cur.V, 0);
    if (MOBA && cur.moba_qb >= 0) { float* kmL = (float*)(lds + LDS_KM_OFF); kmL[tid] = cur.KM[tid]; kmL[tid + 512] = cur.KM[tid + 512]; }
    VMW(); SWRITE_HK(0);
    __syncthreads();
}
template <int PQ, int PKV, int PO, bool MOBA>
__device__ __forceinline__ void attn_block(const BlockRef& cur, const BlockRef& nxt, char* lds, Seam& S) {
    const int tid = threadIdx.x, wid = __builtin_amdgcn_readfirstlane(tid >> 6), lane = tid & 63, r32 = lane & 31, hi = lane >> 5;
    int j_hi = (cur.P0 + QB - 1) / KVBLK + 1; if (j_hi > cur.skv / KVBLK) j_hi = cur.skv / KVBLK;
    const int NT = j_hi;
    const int qlo = cur.P0 + wid * QBLK, qm = qlo + r32 - 4 * hi;
    const int qbm = MOBA ? cur.moba_qb : -1;
    char* V_lds = lds; char* K_lds = lds + 2 * SHM_V;
    float* ws = (float*)(lds + LDS_WS_OFF) + wid * 64; float* li_l = ws, * al_l = ws + 32;
    float m_reg = -1e30f, l_reg = 0; f32x16 o[4] = {};
    const int sr = tid >> 4, sc = (tid & 15) * 8, vst0 = v_st(sr, sc), vst1 = vst0 + 8192  , kws = KSWZ(sr, sc * 2);
    const int vb0 = (int)(uintptr_t)V_lds + v_rd_base(lane);
    const bf16* Kh = cur.K; const bf16* Vh = cur.V;
    unsigned sel = 0xffu;
    if (MOBA && qbm > 3) {
        const float* km = (const float*)(lds + LDS_KM_OFF) + hi * 8;
        const float NEGI = -__builtin_inff();
        float v1 = NEGI, v2 = NEGI, v3 = NEGI; unsigned b1 = 0u, b2 = 0u, b3 = 0u;
#pragma unroll 1
        for (int j = 0; j < qbm; ++j) {
            float a = 0.f;
#pragma unroll
            for (int d0 = 0; d0 < 8; ++d0) {
                const f32x4 k0 = *(const f32x4*)(km + j * 128 + d0 * 16), k1 = *(const f32x4*)(km + j * 128 + d0 * 16 + 4);
                const bf16x8 q = S.qr[d0];
#pragma unroll
                for (int e = 0; e < 4; ++e) { a = fmaf(__uint_as_float((unsigned)(unsigned short)q[e] << 16), k0[e], a); }
#pragma unroll
                for (int e = 0; e < 4; ++e) { a = fmaf(__uint_as_float((unsigned)(unsigned short)q[4 + e] << 16), k1[e], a); }
            }
            a += __shfl_xor(a, 32);
            const unsigned bj = 1u << j;
            const bool g1 = a > v1, g2 = a > v2, g3 = a > v3;
            v3 = g2 ? v2 : (g3 ? a : v3); b3 = g2 ? b2 : (g3 ? bj : b3);
            v2 = g1 ? v1 : (g2 ? a : v2); b2 = g1 ? b1 : (g2 ? bj : b2);
            v1 = g1 ? a : v1;             b1 = g1 ? bj : b1;
        }
        sel = b1 | b2 | b3;
    }
#define RESC(a) do { if (__any((a) < 1.f)) { if (hi == 0) al_l[r32] = (a); asm volatile("s_waitcnt lgkmcnt(0)" ::: "memory");              \
                     for (int d_ = 0; d_ < 4; ++d_) for (int r = 0; r < 16; ++r) o[d_][r] *= al_l[crow(r, hi)]; } } while (0)
#define KBASE(t) ((t) * KVBLK)
#define MASKT(P0_, P1_, t) do { const int kb_ = KBASE(t); const int jb_ = kb_ >> 8;                                                         \
        if (jb_ < qbm) { if (qbm > 3) mask_tile(P0_, P1_, ((sel >> jb_) & 1u) ? (qm - kb_) : -0x40000000, WBIG); }                          \
        else if (kb_ + KVBLK - 1 > qlo) mask_tile(P0_, P1_, qm - kb_, WBIG); } while (0)
    constexpr int NQL = 8;
#define SEAM_K0() do { VMWN(NQL); SWRITE_HK(0); SBAR(); } while (0)
    f32x16 pA0, pA1, pB0, pB1; float mnA, mnB, alA, alB; bf16x8 pa0, pa1, pa2, pa3;
    SWRITE_HV(0); SBAR();
    if (NT > 1) { SLOAD_H(Kh, Vh, KBASE(1)); }
    SBAR(); qkt<0>(pA0, pA1, K_lds, r32, hi, S.qr);
    MASKT(pA0, pA1, 0); partialSM(pA0, pA1, m_reg, mnA, alA);
    if (NT > 1) { VMW(); SWRITE_H(1); }
    __syncthreads();
#define HALF_STEP(PX0, PX1, mnX, alX, PY0, PY1, alY, t, KB, VB, SB) do {                                                      \
        SBAR(); qkt<KB>(PX0, PX1, K_lds, r32, hi, S.qr);                                                                      \
        finishSM(PY0, PY1, alY, l_reg, pa0, pa1, pa2, pa3); SBAR();                                                           \
        if ((t) + 1 < NT) { SLOAD_H(Kh, Vh, KBASE((t) + 1)); SBAR(); }                                                        \
        pv_tile<VB>(o, vb0, pa0, pa1, pa2, pa3); MASKT(PX0, PX1, (t)); partialSM(PX0, PX1, m_reg, mnX, alX);                  \
        __syncthreads();                                                                                                      \
        if ((t) + 1 < NT) { VMW(); SWRITE_H(SB); }                                                                            \
        RESC(alX); __syncthreads(); } while (0)
    for (int t = 1; t + 1 < NT; t += 2) {
        HALF_STEP(pB0, pB1, mnB, alB, pA0, pA1, alA, t, 1, 0, 0);
        HALF_STEP(pA0, pA1, mnA, alA, pB0, pB1, alB, t + 1, 0, 1, 1);
    }
    const bool even = (NT & 1) == 0;
    if (even) { SBAR(); qkt<1>(pB0, pB1, K_lds, r32, hi, S.qr); SBAR(); }
    SLOAD_H(nxt.K, nxt.V, 0); SBAR();
#pragma unroll
    for (int d0 = 0; d0 < 8; ++d0) S.qr[d0] = load8(nxt.Q + (size_t)(wid * QBLK + r32) * PQ + d0 * 16 + hi * 8);
    SBAR();
    finishSM(pA0, pA1, alA, l_reg, pa0, pa1, pa2, pa3); SBAR();
    pv_tile<0>(o, vb0, pa0, pa1, pa2, pa3);
    if (even) { MASKT(pB0, pB1, NT - 1); partialSM(pB0, pB1, m_reg, mnB, alB); __syncthreads(); RESC(alB);
        finishSM(pB0, pB1, alB, l_reg, pa0, pa1, pa2, pa3); SBAR(); pv_tile<1>(o, vb0, pa0, pa1, pa2, pa3); }
    SBAR(); SEAM_K0();
    if (hi == 0) li_l[r32] = l_reg; asm volatile("s_waitcnt lgkmcnt(0)" ::: "memory");
    float rli[16];
#pragma unroll
    for (int r = 0; r < 16; ++r) rli[r] = __builtin_amdgcn_rcpf(li_l[crow(r, hi)]);
    int wq_ = wid; asm volatile("" : "+s"(wq_));
    unsigned loff_ = (unsigned)((4 * hi) * PO + r32) * 2u; asm volatile("" : "+v"(loff_));
    char* Ob = (char*)(cur.O + (size_t)(wq_ * QBLK) * PO);
#pragma unroll
    for (int r = 0; r < 16; ++r) { const int orow0 = (r & 3) + 8 * (r >> 2);
#pragma unroll
        for (int d0 = 0; d0 < 4; ++d0) { const float v = o[d0][r] * rli[r];
            const float vn = __shfl_xor(v, 1);
            if ((r32 & 1) == 0) *(unsigned*)(Ob + ((size_t)orow0 * PO + d0 * 32) * 2 + loff_) = cvtpk(v, vn); } }
    if (MOBA && nxt.moba_qb >= 0) { float* kmL = (float*)(lds + LDS_KM_OFF); const float km0 = nxt.KM[tid], km1 = nxt.KM[tid + 512]; kmL[tid] = km0; kmL[tid + 512] = km1; }
    __syncthreads();
#undef RESC
#undef KBASE
#undef MASKT
#undef SEAM_K0
#undef HALF_STEP
}
#undef ROWP
#undef VMW
#undef VMWN
#undef SLOAD_H
#undef SWRITE_HK
#undef SWRITE_HV
#undef SWRITE_H
#undef KSWZ
#undef SBAR
}

#define GAS __attribute__((address_space(1)))
#define LAS __attribute__((address_space(3)))
typedef unsigned short bf16;
typedef unsigned v4u __attribute__((ext_vector_type(4)));
typedef float f32x4 __attribute__((ext_vector_type(4)));
typedef short bf16x8 __attribute__((ext_vector_type(8)));
typedef GAS unsigned gu32;
typedef GAS unsigned long long gu64;
#define RLX_AGENT __ATOMIC_RELAXED, __HIP_MEMORY_SCOPE_AGENT
#define LDS_WAIT() asm volatile("s_waitcnt lgkmcnt(0)" ::: "memory")
#define VM_WAIT() asm volatile("s_waitcnt vmcnt(0)" ::: "memory")
__device__ __forceinline__ unsigned long long rt() { return __builtin_amdgcn_s_memrealtime(); }
__device__ __forceinline__ unsigned f2bf(float f) { unsigned u = __builtin_bit_cast(unsigned, f); return (u + 0x7fffu + ((u >> 16) & 1u)) >> 16; }
__device__ __forceinline__ unsigned pk2(float lo, float hi) { return f2bf(lo) | (f2bf(hi) << 16); }

#define XB_TMO      128
#define XB_XCNT(j)  (256  + 64 * (j))
#define XB_XSUB(j)  (1280 + 64 * (j))
#define XB_XGEN(j)  (2304 + 64 * (j))
#define XB_TOP      3328
#define XB_TOPGEN   3392
#define XCD_BAR_WORDS 3456
#define XB_SPIN_CAP (1u << 18)

__device__ __forceinline__ unsigned xb_ld(unsigned* p)              { return __hip_atomic_load(p, __ATOMIC_RELAXED, __HIP_MEMORY_SCOPE_AGENT); }
__device__ __forceinline__ unsigned xb_add(unsigned* p, unsigned v) { return __hip_atomic_fetch_add(p, v, __ATOMIC_RELAXED, __HIP_MEMORY_SCOPE_AGENT); }
__device__ __forceinline__ unsigned xb_xcc_id() { return (unsigned)__builtin_amdgcn_s_getreg((3 << 11) | 20) & 0xFu; }
#define XB_SPIN(cond, bar) do { unsigned _sp = 0; while (cond) { __builtin_amdgcn_s_sleep(1); \
    if ((++_sp & 255u) == 0u) { if (xb_ld(&(bar)[XB_TMO])) break; if (_sp > XB_SPIN_CAP) { atomicAdd(&(bar)[XB_TMO], 1u); break; } } } } while (0)

struct XcdBarrier {
    unsigned* bar; unsigned x;
    volatile LAS unsigned* st;
};

__device__ __forceinline__ XcdBarrier xcd_barrier_post(unsigned* bar, volatile LAS unsigned* st) {
    XcdBarrier b; b.bar = bar; b.x = xb_xcc_id(); b.st = st;
    if (threadIdx.x == 0) (void)xb_add(&bar[XB_XCNT(b.x)], 1u);
    return b;
}
__device__ __forceinline__ void xcd_barrier_complete(unsigned* bar, unsigned x, unsigned& nloc, unsigned& nx) {
    const unsigned G = gridDim.x * gridDim.y * gridDim.z;
    unsigned sum, cnt, mine, sp = 0u;
    for (;;) {
        sum = 0u; cnt = 0u; mine = 0u;
#pragma unroll
        for (unsigned j = 0; j < 16; ++j) { const unsigned c = xb_ld(&bar[XB_XCNT(j)]); sum += c; cnt += (c > 0u) ? 1u : 0u; mine = (j == x) ? c : mine; }
        if (sum == G) break;
        __builtin_amdgcn_s_sleep(1);
        if ((++sp & 255u) == 0u) { if (xb_ld(&bar[XB_TMO])) break; if (sp > XB_SPIN_CAP) { atomicAdd(&bar[XB_TMO], 1u); break; } }
    }
    nloc = mine > 0u ? mine : 1u; nx = cnt > 0u ? cnt : 1u;
}

__device__ __forceinline__ void xcd_barrier(const XcdBarrier& b) {
    asm volatile("s_waitcnt vmcnt(0)" ::: "memory");
    __syncthreads();
    if (threadIdx.x == 0) {
        unsigned* bar = b.bar;
        __builtin_amdgcn_s_waitcnt(0);
        unsigned nloc = b.st[0], nx = b.st[1];
        if (nloc == 0u) { xcd_barrier_complete(bar, b.x, nloc, nx); b.st[0] = nloc; b.st[1] = nx; }
        const unsigned old = xb_add(&bar[XB_XSUB(b.x)], 1u);
        const unsigned gen = old / nloc;
        if (old + 1u == (gen + 1u) * nloc) {
            __builtin_amdgcn_fence(__ATOMIC_RELEASE, "agent");
            asm volatile("s_waitcnt vmcnt(0)" ::: "memory");
            const unsigned og = xb_add(&bar[XB_TOP], 1u);
            const unsigned tg = og / nx;
            if (og + 1u == (tg + 1u) * nx) xb_add(&bar[XB_TOPGEN], 1u);
            else XB_SPIN(xb_ld(&bar[XB_TOPGEN]) == tg, bar);
            __builtin_amdgcn_fence(__ATOMIC_ACQUIRE, "agent");
            xb_add(&bar[XB_XGEN(b.x)], 1u);
            asm volatile("s_waitcnt vmcnt(0)" ::: "memory");
        } else {
            XB_SPIN(xb_ld(&bar[XB_XGEN(b.x)]) == gen, bar);
            __builtin_amdgcn_fence(__ATOMIC_ACQUIRE, "agent");
            asm volatile("s_waitcnt vmcnt(0)" ::: "memory");
        }
    }
    __syncthreads();
}


constexpr int NWAVES = 8;
#ifndef MK_N_LAUNCHES
#define MK_N_LAUNCHES 14
#endif
constexpr int NPH = 14;
constexpr int N_LAUNCHES = MK_N_LAUNCHES;
static_assert(N_LAUNCHES == 1 || N_LAUNCHES == NPH, "MK_N_LAUNCHES is 1 or NPH");

constexpr int BATCH = 8, SEQ = 2048, DM = 4096, M = BATCH * SEQ;
constexpr int NIN = 12288, FF = 11008, NGU = 2 * FF, MEML = 256, MM = BATCH * MEML, MW = 512, NKV = 2 * MW;
constexpr int C_QA = 0, C_KA = 2048, C_VA = 4096, C_QB = 6144, C_KB = 8192, C_VB = 10240;
constexpr float NORM_EPS = 1e-6f;
constexpr float LAM_INIT = 0.2f;

constexpr size_t MiB = 1u << 20;
constexpr size_t WS_CTL = 0, CTL_ZERO_BYTES = 1 * MiB;
constexpr size_t WS_ROPE = 1 * MiB;
constexpr size_t WS_KMEAN = WS_ROPE + 512 * 1024;
constexpr size_t WS_W_IN = 2 * MiB;
constexpr size_t WS_W_OUT = WS_W_IN + (size_t)NIN * DM * 2;
constexpr size_t WS_W_MQ = WS_W_OUT + (size_t)DM * DM * 2;
constexpr size_t WS_W_MKV = WS_W_MQ + (size_t)MW * DM * 2;
constexpr size_t WS_W_MO = WS_W_MKV + (size_t)NKV * DM * 2;
constexpr size_t WS_W_GU = WS_W_MO + (size_t)DM * MW * 2;
constexpr size_t WS_W_DN = WS_W_GU + (size_t)NGU * DM * 2;
constexpr size_t WS_XN = WS_W_DN + (size_t)DM * FF * 2;
constexpr size_t WS_PROJ = WS_XN + (size_t)M * DM * 2;
constexpr size_t WS_MIX = WS_PROJ + (size_t)M * NIN * 2;
constexpr size_t WS_MEMN = WS_MIX + (size_t)M * DM * 2;
constexpr size_t WS_KVC = WS_MEMN + (size_t)MM * DM * 2;
constexpr size_t WS_END = WS_KVC + (size_t)MM * NKV * 2;
static_assert(WS_W_IN % MiB == 0 && WS_XN % 256 == 0 && WS_END <= 1140000000ull, "d_ws map");
constexpr int CW_TMO = 0, CW_CODE = 1;
constexpr int CW_BAR = 4096;

constexpr int RING_OFF = 0, RING_BYTES = 131072;
constexpr int LDSCTL_OFF = RING_BYTES, MISC_OFF = LDSCTL_OFF + 320;
constexpr int LDS_BYTES = 147456;
static_assert(MISC_OFF + 128 <= LDS_BYTES && att::LDS_BYTES <= RING_BYTES, "LDS map");

__device__ __forceinline__ float wave_sum(float v) {
#pragma unroll
    for (int o = 1; o < 64; o <<= 1) v += __shfl_xor(v, o);
    return v;
}
__device__ __forceinline__ float bf2f(unsigned short s) { return __uint_as_float((unsigned)s << 16); }
__device__ __forceinline__ void p0_transpose_item(const float* W, int K, int N, bf16* WT, int k0, int n0, int orow0, LAS float* scr, int lane) {
#pragma unroll 8
    for (int i = 0; i < 32; ++i) { const int kk = 2 * i + (lane >> 5); scr[kk * 33 + (lane & 31)] = W[(size_t)(k0 + kk) * N + n0 + (lane & 31)]; }
    LDS_WAIT(); asm volatile("" ::: "memory");
    const int c = lane & 7;
#pragma unroll
    for (int j = 0; j < 4; ++j) { const int n = (lane >> 3) + 8 * j; const LAS float* s = scr + (8 * c) * 33 + n;
        v4u o; o.x = pk2(s[0 * 33], s[1 * 33]); o.y = pk2(s[2 * 33], s[3 * 33]); o.z = pk2(s[4 * 33], s[5 * 33]); o.w = pk2(s[6 * 33], s[7 * 33]);
        *(GAS v4u*)(WT + (size_t)(orow0 + n) * K + k0 + 8 * c) = o; }
    LDS_WAIT(); asm volatile("" ::: "memory");
}
__device__ __forceinline__ void rms_row_to_bf16(const float* xrow, const float* g, bf16* orow, int lane) {
    const GAS f32x4* xr = (const GAS f32x4*)xrow + lane; const GAS f32x4* gr = (const GAS f32x4*)g + lane;
    f32x4 v[16]; float s = 0.f;
#pragma unroll
    for (int j = 0; j < 16; ++j) { v[j] = xr[64 * j]; s += (v[j].x * v[j].x + v[j].y * v[j].y) + (v[j].z * v[j].z + v[j].w * v[j].w); }
    const float rs = 1.0f / sqrtf(wave_sum(s) * (1.f / DM) + NORM_EPS);
    GAS unsigned long long* o8 = (GAS unsigned long long*)orow + lane;
#pragma unroll
    for (int j = 0; j < 16; ++j) { const f32x4 gg = gr[64 * j];
        o8[64 * j] = (unsigned long long)pk2(v[j].x * rs * gg.x, v[j].y * rs * gg.y) | ((unsigned long long)pk2(v[j].z * rs * gg.z, v[j].w * rs * gg.w) << 32); }
}
__device__ __forceinline__ void normrope_unit(bf16* T, int pitch, int row0, int c0, const float* g, const float* rope, float* km, LAS float* scr, int tid) {
    const int wave = tid >> 6, lane = tid & 63, rsub = lane >> 4, c = lane & 15;
    float gv[8];
    { const f32x4 g0 = *(const f32x4*)(g + 8 * c), g1 = *(const f32x4*)(g + 8 * c + 4); gv[0] = g0.x; gv[1] = g0.y; gv[2] = g0.z; gv[3] = g0.w; gv[4] = g1.x; gv[5] = g1.y; gv[6] = g1.z; gv[7] = g1.w; }
    float csum[8];
#pragma unroll
    for (int e = 0; e < 8; ++e) csum[e] = 0.f;
#pragma unroll 2
    for (int it = 0; it < 8; ++it) {
        const int r = row0 + wave * 32 + it * 4 + rsub;
        bf16* p = T + (size_t)r * pitch + c0 + 8 * c;
        const v4u raw = *(const v4u*)p;
        float y[8];
        y[0] = __uint_as_float(raw.x << 16); y[1] = __uint_as_float(raw.x & 0xffff0000u); y[2] = __uint_as_float(raw.y << 16); y[3] = __uint_as_float(raw.y & 0xffff0000u);
        y[4] = __uint_as_float(raw.z << 16); y[5] = __uint_as_float(raw.z & 0xffff0000u); y[6] = __uint_as_float(raw.w << 16); y[7] = __uint_as_float(raw.w & 0xffff0000u);
        float ss = 0.f;
#pragma unroll
        for (int e = 0; e < 8; ++e) ss += y[e] * y[e];
        ss += __shfl_xor(ss, 1); ss += __shfl_xor(ss, 2); ss += __shfl_xor(ss, 4); ss += __shfl_xor(ss, 8);
        const float rs = 1.0f / sqrtf(ss * (1.f / 128.f) + NORM_EPS);
#pragma unroll
        for (int e = 0; e < 8; ++e) y[e] = y[e] * rs * gv[e];
        if (rope) {
            float pr[8];
#pragma unroll
            for (int e = 0; e < 8; ++e) pr[e] = __shfl_xor(y[e], 2);
            if (c < 4) {
                const float* cs = rope + (size_t)(r & (SEQ - 1)) * 32 + (c & 1) * 8;
                const f32x4 c0v = *(const f32x4*)cs, c1v = *(const f32x4*)(cs + 4), s0v = *(const f32x4*)(cs + 16), s1v = *(const f32x4*)(cs + 20);
                const float cc[8] = {c0v.x, c0v.y, c0v.z, c0v.w, c1v.x, c1v.y, c1v.z, c1v.w}, sn[8] = {s0v.x, s0v.y, s0v.z, s0v.w, s1v.x, s1v.y, s1v.z, s1v.w};
                const float sg = (c < 2) ? -1.f : 1.f;
#pragma unroll
                for (int e = 0; e < 8; ++e) y[e] = y[e] * cc[e] + sg * pr[e] * sn[e];
            }
        }
#pragma unroll
        for (int e = 0; e < 8; ++e) csum[e] += y[e];
        v4u o; o.x = pk2(y[0], y[1]); o.y = pk2(y[2], y[3]); o.z = pk2(y[4], y[5]); o.w = pk2(y[6], y[7]);
        *(v4u*)p = o;
    }
    if (km) {
#pragma unroll
        for (int e = 0; e < 8; ++e) { csum[e] += __shfl_xor(csum[e], 16); csum[e] += __shfl_xor(csum[e], 32); }
        if (rsub == 0) {
#pragma unroll
            for (int e = 0; e < 8; ++e) scr[wave * 128 + 8 * c + e] = csum[e]; }
        __syncthreads();
        if (tid < 128) { float s = 0.f;
#pragma unroll
            for (int w = 0; w < 8; ++w) s += scr[w * 128 + tid];
            km[tid] = s * (1.f / 256.f); }
        __syncthreads();
    }
}


__device__ __forceinline__ att::BlockRef attn_get(int idx, int G, int vcu, bf16* PROJ, bf16* MIX, bf16* DO, float* KMEAN) {
    const int p = idx >> 1, pass = idx & 1, I = p * G + vcu, xq = I & 3, hua = I >> 2, b = hua / 48, hu = hua % 48, qb = pass ? 7 - xq : xq;
    const size_t rq = (size_t)b * SEQ + (size_t)qb * 256, rk = (size_t)b * SEQ;
    att::BlockRef r;
    if (hu < 16) { r.Q = PROJ + rq * NIN + C_QA + hu * 128; r.K = PROJ + rk * NIN + C_KA + hu * 128; r.V = PROJ + rk * NIN + C_VA + hu * 128; r.O = MIX + rq * DM + hu * 128;
                   r.KM = KMEAN + (size_t)(b * 16 + hu) * 8 * 128; r.moba_qb = qb; }
    else { const int d = hu - 16, dh = d >> 2, s = (d >> 1) & 1, vh = d & 1;
           r.Q = PROJ + rq * NIN + C_QB + dh * 256 + s * 128; r.K = PROJ + rk * NIN + C_KB + dh * 256 + s * 128; r.V = PROJ + rk * NIN + C_VB + dh * 256 + vh * 128;
           r.O = DO + rq * DM + dh * 512 + s * 256 + vh * 128; r.KM = KMEAN; r.moba_qb = -1; }
    r.P0 = qb * 256; r.skv = SEQ;
    return r;
}

struct Args { const float* in[26]; float* out; unsigned char* ws; int ph_lo, ph_hi, li, pad; };
__global__ void __launch_bounds__(NWAVES * 64, 2) mk_fwd(Args args) {
    extern __shared__ __attribute__((aligned(16))) unsigned char lds[];
    LAS unsigned char* const ldsL = (LAS unsigned char*)lds;
    volatile LAS unsigned* const MISC = (volatile LAS unsigned*)(ldsL + MISC_OFF);
    const int tid = threadIdx.x, lane = tid & 63, wave = __builtin_amdgcn_readfirstlane(tid >> 6);
    const int G = gridDim.x, bx = blockIdx.x, vcu = (G % 8 == 0) ? (bx % 8) * (G / 8) + bx / 8 : bx;
    unsigned char* const ws = args.ws;
    gu32* const ctl = (gu32*)(ws + WS_CTL);
    const float* const x = args.in[0]; float* const out = args.out;
    float* const ROPE = (float*)(ws + WS_ROPE); float* const KMEAN = (float*)(ws + WS_KMEAN);
    bf16* const W_IN = (bf16*)(ws + WS_W_IN); bf16* const W_OUT = (bf16*)(ws + WS_W_OUT); bf16* const W_MQ = (bf16*)(ws + WS_W_MQ); bf16* const W_MKV = (bf16*)(ws + WS_W_MKV);
    bf16* const W_MO = (bf16*)(ws + WS_W_MO); bf16* const W_GU = (bf16*)(ws + WS_W_GU); bf16* const W_DN = (bf16*)(ws + WS_W_DN);
    bf16* const XN = (bf16*)(ws + WS_XN); bf16* const PROJ = (bf16*)(ws + WS_PROJ); bf16* const MIX = (bf16*)(ws + WS_MIX); bf16* const MEMN = (bf16*)(ws + WS_MEMN); bf16* const KVC = (bf16*)(ws + WS_KVC);
    bf16* const DO = XN; bf16* const HB = PROJ; bf16* const QC = MIX; bf16* const OC = MIX + (size_t)16 * MiB / 2;
    for (int u = tid; u < (LDS_BYTES - LDSCTL_OFF) / 4; u += NWAVES * 64) ((LAS unsigned*)(ldsL + LDSCTL_OFF))[u] = 0u;
    __syncthreads();
    XcdBarrier bar; bar.bar = (unsigned*)(ctl + CW_BAR); bar.x = 0; bar.st = nullptr;
    if (N_LAUNCHES == 1) bar = xcd_barrier_post((unsigned*)(ctl + CW_BAR), MISC + 8);
#define GRID_BAR(seam) do { if (N_LAUNCHES != 1) { if (tid == 0) __hip_atomic_store(ctl + CW_TMO, 0xBADBA0u | (unsigned)(seam), RLX_AGENT); } else { xcd_barrier(bar); } } while (0)
    const int lo = args.ph_lo, hi = args.ph_hi;
#ifndef PH_MASK
#define PH_MASK 0x3fff
#endif
#define IN(k) ((((PH_MASK) >> (k)) & 1) && lo <= (k) && (k) < hi)
#define BOTH(k) (IN(k) && IN((k) + 1))
    const int gw = vcu * NWAVES + wave, NGW = G * NWAVES;

    if (IN(0)) {
        LAS float* scr = (LAS float*)(ldsL + RING_OFF + wave * 16384);
        constexpr int I_IN = (DM / 64) * (NIN / 32), I_OUT = (DM / 64) * (DM / 32), I_MQ = (DM / 64) * (MW / 32), I_MO = (MW / 64) * (DM / 32), I_G = (DM / 64) * (FF / 32), I_DN = (FF / 64) * (DM / 32);
        constexpr int NITEMS = I_IN + I_OUT + 3 * I_MQ + I_MO + 2 * I_G + I_DN;
        for (int it = gw; it < NITEMS; it += NGW) {
            int r = it;
            if (r < I_IN) { const int nb = NIN / 32, kb = r / nb, n0 = 32 * (r % nb); p0_transpose_item(args.in[3], DM, NIN, W_IN, 64 * kb, n0, n0, scr, lane); continue; } r -= I_IN;
            if (r < I_OUT) { const int nb = DM / 32, kb = r / nb, n0 = 32 * (r % nb); p0_transpose_item(args.in[13], DM, DM, W_OUT, 64 * kb, n0, n0, scr, lane); continue; } r -= I_OUT;
            if (r < I_MQ) { const int nb = MW / 32, kb = r / nb, n0 = 32 * (r % nb); p0_transpose_item(args.in[16], DM, MW, W_MQ, 64 * kb, n0, n0, scr, lane); continue; } r -= I_MQ;
            if (r < I_MQ) { const int nb = MW / 32, kb = r / nb, n0 = 32 * (r % nb); p0_transpose_item(args.in[17], DM, MW, W_MKV, 64 * kb, n0, n0, scr, lane); continue; } r -= I_MQ;
            if (r < I_MQ) { const int nb = MW / 32, kb = r / nb, n0 = 32 * (r % nb); p0_transpose_item(args.in[18], DM, MW, W_MKV, 64 * kb, n0, MW + n0, scr, lane); continue; } r -= I_MQ;
            if (r < I_MO) { const int nb = DM / 32, kb = r / nb, n0 = 32 * (r % nb); p0_transpose_item(args.in[19], MW, DM, W_MO, 64 * kb, n0, n0, scr, lane); continue; } r -= I_MO;
            if (r < I_G) { const int nb = FF / 32, kb = r / nb, n0 = 32 * (r % nb); p0_transpose_item(args.in[23], DM, FF, W_GU, 64 * kb, n0, 256 * (n0 / 128) + (n0 % 128), scr, lane); continue; } r -= I_G;
            if (r < I_G) { const int nb = FF / 32, kb = r / nb, n0 = 32 * (r % nb); p0_transpose_item(args.in[24], DM, FF, W_GU, 64 * kb, n0, 256 * (n0 / 128) + 128 + (n0 % 128), scr, lane); continue; } r -= I_G;
            { const int nb = DM / 32, kb = r / nb, n0 = 32 * (r % nb); p0_transpose_item(args.in[25], FF, DM, W_DN, 64 * kb, n0, n0, scr, lane); }
        }
        for (int m = gw; m < M; m += NGW) rms_row_to_bf16(x + (size_t)m * DM, args.in[2], XN + (size_t)m * DM, lane);
        for (int m = gw; m < MM; m += NGW) rms_row_to_bf16(args.in[1] + (size_t)m * DM, args.in[15], MEMN + (size_t)m * DM, lane);
        for (int e = bx * (NWAVES * 64) + tid; e < SEQ * 16; e += G * NWAVES * 64) {
            const int pos = e >> 4, i = e & 15;
            const float inv = powf(500000.0f, -(float)(2 * i) / 32.0f);
            const float ang = (float)pos * inv;
            ROPE[pos * 32 + i] = cosf(ang); ROPE[pos * 32 + 16 + i] = sinf(ang);
        }
        if (BOTH(0)) GRID_BAR(0);
    }
    if (IN(1)) {
        pg8::Gemm g{XN, W_IN, M, NIN, DM}; pg8::StaticOrder S; S.init(M, NIN, G, bx);
        pg8::EpiBf16<0> E{PROJ, NIN, nullptr, 0, 0, 1.f};
        pg8::gemm_phase<pg8::EpiBf16<0>, pg8::StaticOrder, PG8_ALIGN, PG8_SP2>(ldsL + RING_OFF, g, S, E);
        if (BOTH(1)) GRID_BAR(1);
    }
    if (IN(2)) {
        LAS float* scr = (LAS float*)(ldsL + RING_OFF);
        for (int u = vcu; u < 64 * 64; u += G) {
            const int pm = u >> 6, ch = u & 63;
            int c0; const float* g; float* km = nullptr;
            if (ch < 16) { c0 = C_QA + ch * 128; g = args.in[4]; }
            else if (ch < 32) { c0 = C_KA + (ch - 16) * 128; g = args.in[5]; km = KMEAN + ((size_t)((pm >> 3) * 16 + (ch - 16)) * 8 + (pm & 7)) * 128; }
            else if (ch < 48) { c0 = C_QB + (ch - 32) * 128; g = args.in[6]; }
            else { c0 = C_KB + (ch - 48) * 128; g = args.in[7]; }
            normrope_unit(PROJ, NIN, pm * 256, c0, g, ROPE, km, scr, tid);
        }
        if (BOTH(2)) GRID_BAR(2);
    }
    if (IN(3)) {
#define get(idx) attn_get((idx), G, vcu, PROJ, MIX, DO, KMEAN)
        const int nblk = 2 * ((BATCH * 48 * 4) / G);
        if ((BATCH * 48 * 4) % G == 0) {
            att::BlockRef cur = get(0); att::Seam S; att::attn_prime<NIN, NIN, DM, true>(cur, (char*)lds + RING_OFF, S);
            for (int i = 0; i < nblk; ++i) { const att::BlockRef nxt = (i + 1 < nblk) ? get(i + 1) : cur; att::attn_block<NIN, NIN, DM, true>(cur, nxt, (char*)lds + RING_OFF, S); cur = nxt; }
        }
#undef get
        if (BOTH(3)) GRID_BAR(3);
    }
    if (IN(4)) {
        float lam;
        { const float a = args.in[8][lane] * args.in[9][lane] + args.in[8][lane + 64] * args.in[9][lane + 64];
          const float b = args.in[10][lane] * args.in[11][lane] + args.in[10][lane + 64] * args.in[11][lane + 64];
          lam = expf(wave_sum(a)) - expf(wave_sum(b)) + LAM_INIT; }
        const int half = lane >> 5, l5 = lane & 31;
        float gv[8];
        { const f32x4 g0 = *(const f32x4*)(args.in[12] + 8 * l5), g1 = *(const f32x4*)(args.in[12] + 8 * l5 + 4); gv[0] = g0.x; gv[1] = g0.y; gv[2] = g0.z; gv[3] = g0.w; gv[4] = g1.x; gv[5] = g1.y; gv[6] = g1.z; gv[7] = g1.w; }
        for (int it = gw; it < M * 8 / 2; it += NGW) {
            const int q = it * 2 + half, row = q >> 3, dh = q & 7;
            const bf16* p1 = DO + (size_t)row * DM + dh * 512 + 8 * l5;
            const v4u a = *(const v4u*)p1, b = *(const v4u*)(p1 + 256);
            const unsigned aw[4] = {a.x, a.y, a.z, a.w}, bw[4] = {b.x, b.y, b.z, b.w};
            float o[8]; float ss = 0.f;
#pragma unroll
            for (int e = 0; e < 4; ++e) { o[2 * e] = __uint_as_float(aw[e] << 16) - lam * __uint_as_float(bw[e] << 16); o[2 * e + 1] = __uint_as_float(aw[e] & 0xffff0000u) - lam * __uint_as_float(bw[e] & 0xffff0000u); }
#pragma unroll
            for (int e = 0; e < 8; ++e) ss += o[e] * o[e];
            ss += __shfl_xor(ss, 1); ss += __shfl_xor(ss, 2); ss += __shfl_xor(ss, 4); ss += __shfl_xor(ss, 8); ss += __shfl_xor(ss, 16);
            const float rs = (1.0f - LAM_INIT) / sqrtf(ss * (1.f / 256.f) + NORM_EPS);
            v4u w; w.x = pk2(o[0] * rs * gv[0], o[1] * rs * gv[1]); w.y = pk2(o[2] * rs * gv[2], o[3] * rs * gv[3]); w.z = pk2(o[4] * rs * gv[4], o[5] * rs * gv[5]); w.w = pk2(o[6] * rs * gv[6], o[7] * rs * gv[7]);
            *(v4u*)(MIX + (size_t)row * DM + 2048 + dh * 256 + 8 * l5) = w;
        }
        if (BOTH(4)) GRID_BAR(4);
    }
    if (IN(5)) {
        pg8::Gemm g{MIX, W_OUT, M, DM, DM}; pg8::StaticOrder S; S.init(M, DM, G, bx);
        pg8::EpiResF32 E{x, out, DM};
        pg8::gemm_phase<pg8::EpiResF32, pg8::StaticOrder, PG8_ALIGN, PG8_SP2>(ldsL + RING_OFF, g, S, E);
        if (BOTH(5)) GRID_BAR(5);
    }
    if (IN(6)) {
        for (int m = gw; m < M; m += NGW) rms_row_to_bf16(out + (size_t)m * DM, args.in[14], XN + (size_t)m * DM, lane);
        if (BOTH(6)) GRID_BAR(6);
    }
    if (IN(7)) {
        { pg8::Gemm g{XN, W_MQ, M, MW, DM}; pg8::StaticOrder S; S.init(M, MW, G, bx);
          pg8::EpiBf16<0> E{QC, MW, nullptr, 0, 0, 1.f};
          pg8::gemm_phase<pg8::EpiBf16<0>, pg8::StaticOrder, PG8_ALIGN, PG8_SP2>(ldsL + RING_OFF, g, S, E); }
        { pg8::Gemm g{MEMN, W_MKV, MM, NKV, DM}; pg8::StaticOrder S; S.init(MM, NKV, G, (bx + G - 128) % G);
          pg8::EpiBf16<0> E{KVC, NKV, nullptr, 0, 0, 1.f};
          pg8::gemm_phase<pg8::EpiBf16<0>, pg8::StaticOrder, PG8_ALIGN, PG8_SP2>(ldsL + RING_OFF, g, S, E); }
        if (BOTH(7)) GRID_BAR(7);
    }
    if (IN(8)) {
        LAS float* scr = (LAS float*)(ldsL + RING_OFF);
        for (int u = vcu; u < 64 * 4 + 8 * 4; u += G) {
            if (u < 256) normrope_unit(QC, MW, (u >> 2) * 256, (u & 3) * 128, args.in[20], nullptr, nullptr, scr, tid);
            else { const int v = u - 256; normrope_unit(KVC, NKV, (v >> 2) * 256, (v & 3) * 128, args.in[21], nullptr, nullptr, scr, tid); }
        }
        if (BOTH(8)) GRID_BAR(8);
    }
    if (IN(9)) {
        for (int I = vcu; I < BATCH * 4 * 8; I += G) {
            const int b = I >> 5, h = (I >> 3) & 3, qb = I & 7;
            att::BlockRef r; const size_t rq = (size_t)b * SEQ + (size_t)qb * 256, rk = (size_t)b * MEML;
            r.Q = QC + rq * MW + h * 128; r.K = KVC + rk * NKV + h * 128; r.V = KVC + rk * NKV + MW + h * 128; r.O = OC + rq * MW + h * 128; r.KM = KMEAN; r.moba_qb = -1;
            r.P0 = 1 << 20; r.skv = MEML;
            att::Seam S; att::attn_prime<MW, NKV, MW, false>(r, (char*)lds + RING_OFF, S); att::attn_block<MW, NKV, MW, false>(r, r, (char*)lds + RING_OFF, S);
        }
        if (BOTH(9)) GRID_BAR(9);
    }
    if (IN(10)) {
        pg8::Gemm g{OC, W_MO, M, DM, MW}; pg8::StaticOrder S; S.init(M, DM, G, bx);
        pg8::EpiResF32 E{out, out, DM};
        pg8::gemm_phase<pg8::EpiResF32, pg8::StaticOrder, PG8_ALIGN, PG8_SP2>(ldsL + RING_OFF, g, S, E);
        if (BOTH(10)) GRID_BAR(10);
    }
    if (IN(11)) {
        for (int m = gw; m < M; m += NGW) rms_row_to_bf16(out + (size_t)m * DM, args.in[22], XN + (size_t)m * DM, lane);
        if (BOTH(11)) GRID_BAR(11);
    }
    if (IN(12)) {
        pg8::Gemm g{XN, W_GU, M, NGU, DM}; pg8::StaticOrder S; S.init(M, NGU, G, bx);
        pg8::EpiSwiGLU E{HB, FF};
        pg8::gemm_phase<pg8::EpiSwiGLU, pg8::StaticOrder, PG8_ALIGN, PG8_SP2>(ldsL + RING_OFF, g, S, E);
        if (BOTH(12)) GRID_BAR(12);
    }
    if (IN(13)) {
        pg8::Gemm g{HB, W_DN, M, DM, FF}; pg8::StaticOrder S; S.init(M, DM, G, bx);
        pg8::EpiResF32 E{out, out, DM};
        pg8::gemm_phase<pg8::EpiResF32, pg8::StaticOrder, PG8_ALIGN, PG8_SP2>(ldsL + RING_OFF, g, S, E);
    }
#undef IN
#undef BOTH
}

extern "C" void kernel_launch(void* const* d_in, const int* in_sizes, int n_in, void* d_out, int out_size, void* d_ws, size_t ws_size, hipStream_t stream) {
    static int grid = 0;
    if (grid == 0) {
        if (n_in != 26 || in_sizes[0] != M * DM || out_size != M * DM || ws_size < WS_END) { fprintf(stderr, "kernel_launch: shape/workspace mismatch (n_in %d, in0 %d, out %d, ws %zu, need %zu)\n", n_in, n_in > 0 ? in_sizes[0] : -1, out_size, ws_size, (size_t)WS_END); grid = -1; return; }
        int dev = 0, cus = 0, per_cu = 0;
        if (hipGetDevice(&dev) != hipSuccess || hipDeviceGetAttribute(&cus, hipDeviceAttributeMultiprocessorCount, dev) != hipSuccess) { grid = -1; return; }
        if (hipFuncSetAttribute((const void*)mk_fwd, hipFuncAttributeMaxDynamicSharedMemorySize, LDS_BYTES) != hipSuccess) { fprintf(stderr, "kernel_launch: hipFuncSetAttribute failed\n"); grid = -1; return; }
        if (hipOccupancyMaxActiveBlocksPerMultiprocessor(&per_cu, (const void*)mk_fwd, NWAVES * 64, LDS_BYTES) != hipSuccess || per_cu < 1)
            fprintf(stderr, "kernel_launch: note: occupancy query reports %d workgroups per CU\n", per_cu);
        (void)hipGetLastError();
        grid = cus;
    }
    if (grid < 0) return;
    if (hipMemsetAsync((char*)d_ws + WS_CTL, 0, CTL_ZERO_BYTES, stream) != hipSuccess) return;
    Args a{};
    for (int i = 0; i < 26; ++i) a.in[i] = (const float*)d_in[i];
    a.out = (float*)d_out; a.ws = (unsigned char*)d_ws;
    for (int li = 0; li < N_LAUNCHES; ++li) {
        a.ph_lo = (N_LAUNCHES == NPH) ? li : 0; a.ph_hi = (N_LAUNCHES == NPH) ? li + 1 : NPH; a.li = li; a.pad = 0;
        hipLaunchKernelGGL(mk_fwd, dim3(grid), dim3(NWAVES * 64), LDS_BYTES, stream, a);
        const hipError_t le = hipPeekAtLastError();
        if (le != hipSuccess) { fprintf(stderr, "kernel_launch: launch %d failed: %s\n", li, hipGetErrorName(le)); break; }
    }
}
```

```cpp
#include <hip/hip_runtime.h>
#include <cstdio>
#include <cstdint>
namespace pg8 {
#define PG8_LAS __attribute__((address_space(3)))
typedef unsigned short bf16_t;
typedef short bf16x8 __attribute__((ext_vector_type(8)));
typedef float f32x4 __attribute__((ext_vector_type(4)));
typedef unsigned u32x4 __attribute__((ext_vector_type(4)));
constexpr int BM = 256, BK = 64, HALF = 128, HTB = HALF * BK * 2  , STAGE_BYTES = 8 * HTB, NXCD = 8, WGM = 8;

__host__ __device__ __forceinline__ int lds_byte(int r, int c) { const int st = (r >> 4) * 2 + (c >> 5), rr = r & 15, cc = c & 31, ob = rr * 64 + cc * 2; return st * 1024 + (ob ^ (((ob >> 9) & 1) << 5)); }
__host__ __device__ __forceinline__ void stage_rc(int b, int& R, int& C) { const int st = b / 1024, sb = b % 1024, swz = sb ^ (((sb >> 9) & 1) << 5); R = (st >> 1) * 16 + swz / 64; C = (st & 1) * 32 + (swz % 64) / 2; }
__host__ __device__ __forceinline__ int perm32(int rho) { const int n = rho >> 4, i = rho & 15; return 8 * (i >> 2) + 4 * n + (i & 3); }

struct Unit { int pm, pn; };
struct Gemm { const bf16_t* A; const bf16_t* Bt; int M, N, K; };

struct StaticOrder {
    int nM, nN, nwg, G, c, rot, wgm;
    __host__ __device__ void init(int M, int N, int G_, int c_, int rot_ = 0, int wgm_ = WGM) { nM = M / BM; nN = N / BM; nwg = nM * nN; G = G_; c = c_; rot = rot_; wgm = wgm_; }
    __host__ __device__ __forceinline__ bool next(int i, Unit& u) const {
        const long L = (long)i * G + c; if (L >= nwg) return false;
        int wgid = (int)L; { const int q = nwg / NXCD, r = nwg % NXCD, xcd = wgid % NXCD, off = wgid / NXCD; wgid = (xcd < r ? xcd * (q + 1) : r * (q + 1) + (xcd - r) * q) + off; }
        const int nig = wgm * nN, gid = wgid / nig, fm = gid * wgm, gsz = (nM - fm) < wgm ? (nM - fm) : wgm;
        u.pm = fm + ((wgid % nig) % gsz); u.pn = ((wgid % nig) / gsz + rot * gid) % nN; return true;
    }
    __device__ __forceinline__ void a_ready(const Unit&) const {}
    __device__ __forceinline__ void done(const Unit&) const {}
};

__device__ __forceinline__ unsigned cvt_pk_bf16(float lo, float hi) { unsigned r; asm volatile("v_cvt_pk_bf16_f32 %0, %1, %2" : "=v"(r) : "v"(lo), "v"(hi)); return r; }
typedef float f32x2 __attribute__((ext_vector_type(2)));
__device__ __forceinline__ f32x2 gelu_pk(f32x2 v) {
    const f32x2 av = __builtin_elementwise_abs(v), d = av * 0.2316418882f + 1.0f;
    f32x2 t; t.x = __builtin_amdgcn_rcpf(d.x); t.y = __builtin_amdgcn_rcpf(d.y);
    f32x2 q = t * 0.5307027145f + (-0.7265760135f); q = q * t + 0.7107068705f; q = q * t + (-0.142248368f); q = q * t + 0.127414796f; q = q * t;
    const f32x2 s = (v * v) * (-0.72134752044f);
    f32x2 e; e.x = __builtin_amdgcn_exp2f(s.x); e.y = __builtin_amdgcn_exp2f(s.y);
    const f32x2 m = v * (q * e), r = v - m;
    f32x2 o; o.x = v.x < 0.f ? m.x : r.x; o.y = v.y < 0.f ? m.y : r.y; return o;
}

template <int ACT  > struct EpiBf16 {
    static constexpr bool PERM = true, AFTER_DRAIN = false, PRELOAD = false; static_assert(ACT == 0 || ACT == 1, "EpiBf16: ACT is 0 (none) or 1 (gelu_pk)");
    bf16_t* O; int ldc; const float* bias; int split_cols; size_t split_stride; float scale0;
    __device__ __forceinline__ void operator()(const f32x4 (&acc)[2][2][4][2], const Unit& u, int wr, int wc, int fr, int fq) const {
        const int row0 = u.pm * BM + wr * 64 + fr; int colt = u.pn * BM; bf16_t* base = O;
        float sc = 1.f; if (split_cols) { const int t = colt / split_cols; base += (size_t)t * split_stride; colt -= t * split_cols; if (t == 0) sc = scale0; }
        const int col0 = colt + wc * 32 + 8 * fq, bcol0 = u.pn * BM + wc * 32 + 8 * fq;
        f32x4 bv[2][2];
#pragma unroll
        for (int bj = 0; bj < 2; ++bj)
#pragma unroll
            for (int n = 0; n < 2; ++n) bv[bj][n] = bias ? *(const f32x4*)(bias + bcol0 + bj * HALF + 4 * n) : (f32x4){0.f, 0.f, 0.f, 0.f};
#pragma unroll
        for (int ai = 0; ai < 2; ++ai)
#pragma unroll
            for (int m = 0; m < 4; ++m) { bf16_t* rowp = base + (size_t)(row0 + ai * HALF + m * 16) * ldc + col0;
#pragma unroll
                for (int bj = 0; bj < 2; ++bj) { f32x4 v0 = acc[ai][bj][m][0] + bv[bj][0], v1 = acc[ai][bj][m][1] + bv[bj][1];
                    if (ACT == 1) { f32x2 a = gelu_pk((f32x2){v0[0], v0[1]}), b = gelu_pk((f32x2){v0[2], v0[3]}), c = gelu_pk((f32x2){v1[0], v1[1]}), d = gelu_pk((f32x2){v1[2], v1[3]});
                        v0 = (f32x4){a.x, a.y, b.x, b.y}; v1 = (f32x4){c.x, c.y, d.x, d.y}; }
                    v0 = v0 * sc; v1 = v1 * sc; u32x4 w; w.x = cvt_pk_bf16(v0[0], v0[1]); w.y = cvt_pk_bf16(v0[2], v0[3]); w.z = cvt_pk_bf16(v1[0], v1[1]); w.w = cvt_pk_bf16(v1[2], v1[3]);
                    *(u32x4*)(rowp + bj * HALF) = w; } }
    }
};


struct EpiResF32 {
    static constexpr bool PERM = false, AFTER_DRAIN = false, PRELOAD = false;
    const float* base; float* out; int ldc;
    __device__ __forceinline__ void operator()(const f32x4 (&acc)[2][2][4][2], const Unit& u, int wr, int wc, int fr, int fq) const {
        const int row0 = u.pm * BM + wr * 64 + fr, col0 = u.pn * BM + wc * 32 + 4 * fq;
#pragma unroll
        for (int ai = 0; ai < 2; ++ai)
#pragma unroll
            for (int m = 0; m < 4; ++m) { const size_t off = (size_t)(row0 + ai * HALF + m * 16) * ldc + col0;
                f32x4 b[2][2];
#pragma unroll
                for (int bj = 0; bj < 2; ++bj)
#pragma unroll
                    for (int n = 0; n < 2; ++n) b[bj][n] = *(const f32x4*)(base + off + bj * HALF + n * 16);
#pragma unroll
                for (int bj = 0; bj < 2; ++bj)
#pragma unroll
                    for (int n = 0; n < 2; ++n) *(f32x4*)(out + off + bj * HALF + n * 16) = b[bj][n] + acc[ai][bj][m][n];
                if (m & 1) asm volatile("" ::: "memory"); }
    }
};
struct EpiSwiGLU {
    static constexpr bool PERM = true, AFTER_DRAIN = false, PRELOAD = true;
    __device__ __forceinline__ void preload(float (&pre)[8], const Unit& u, int wr, int fr) const {
#pragma unroll
        for (int i = 0; i < 8; ++i) { const float* p = RS + u.pm * BM + (i >> 2) * HALF + wr * 64 + (i & 3) * 16 + fr;
            asm volatile("global_load_dword %0, %1, off" : "=&v"(pre[i]) : "v"(p) : "memory"); } }
    bf16_t* H; int ldh; const float* RS;
    __device__ __forceinline__ void operator()(const f32x4 (&acc)[2][2][4][2], const Unit& u, int wr, int wc, int fr, int fq, const float (&pre)[8]) const {
        const int row0 = u.pm * BM + wr * 64 + fr, col0 = u.pn * HALF + wc * 32 + 8 * fq;
#pragma unroll
        for (int ai = 0; ai < 2; ++ai)
#pragma unroll
            for (int m = 0; m < 4; ++m) { const int row = row0 + ai * HALF + m * 16; bf16_t* rowp = H + (size_t)row * ldh + col0;
                const float rs = pre[ai * 4 + m], c1 = rs * -1.4426950408889634f, c2 = rs * rs;
                float h[8];
#pragma unroll
                for (int n = 0; n < 2; ++n)
#pragma unroll
                    for (int e = 0; e < 4; e += 2) { const f32x2 a0 = {acc[ai][0][m][n][e], acc[ai][0][m][n][e + 1]}, a1 = {acc[ai][1][m][n][e], acc[ai][1][m][n][e + 1]};
                        const f32x2 t = a0 * c1; f32x2 d; d.x = __builtin_amdgcn_exp2f(t.x); d.y = __builtin_amdgcn_exp2f(t.y); d = d + 1.0f;
                        f32x2 r; r.x = __builtin_amdgcn_rcpf(d.x); r.y = __builtin_amdgcn_rcpf(d.y);
                        const f32x2 o = ((a0 * a1) * c2) * r; h[n * 4 + e] = o.x; h[n * 4 + e + 1] = o.y; }
                u32x4 w; w.x = cvt_pk_bf16(h[0], h[1]); w.y = cvt_pk_bf16(h[2], h[3]); w.z = cvt_pk_bf16(h[4], h[5]); w.w = cvt_pk_bf16(h[6], h[7]);
                *(u32x4*)rowp = w; }
    }
};

template <bool BASE_BF16> struct EpiResNorm {
    static constexpr bool PERM = true, AFTER_DRAIN = false, PRELOAD = false;
    const float* base; bf16_t* XB; float* PS; int ldc, nps;
    __device__ __forceinline__ void operator()(const f32x4 (&acc)[2][2][4][2], const Unit& u, int wr, int wc, int fr, int fq) const {
        const int row0 = u.pm * BM + wr * 64 + fr, col0 = u.pn * BM + wc * 32 + 8 * fq;
#pragma unroll
        for (int ai = 0; ai < 2; ++ai)
#pragma unroll
            for (int m = 0; m < 4; ++m) { const int row = row0 + ai * HALF + m * 16; const size_t off = (size_t)row * ldc + col0;
                f32x4 b[2][2];
#pragma unroll
                for (int bj = 0; bj < 2; ++bj) {
                    if constexpr (BASE_BF16) { const u32x4 r = *(const u32x4*)(XB + off + bj * HALF);
                        b[bj][0] = (f32x4){__uint_as_float(r.x << 16), __uint_as_float(r.x & 0xffff0000u), __uint_as_float(r.y << 16), __uint_as_float(r.y & 0xffff0000u)};
                        b[bj][1] = (f32x4){__uint_as_float(r.z << 16), __uint_as_float(r.z & 0xffff0000u), __uint_as_float(r.w << 16), __uint_as_float(r.w & 0xffff0000u)}; }
                    else { b[bj][0] = *(const f32x4*)(base + off + bj * HALF); b[bj][1] = *(const f32x4*)(base + off + bj * HALF + 4); } }
                float ss = 0.f;
#pragma unroll
                for (int bj = 0; bj < 2; ++bj) { const f32x4 v0 = b[bj][0] + acc[ai][bj][m][0], v1 = b[bj][1] + acc[ai][bj][m][1];
                    ss += (v0[0] * v0[0] + v0[1] * v0[1]) + (v0[2] * v0[2] + v0[3] * v0[3]) + (v1[0] * v1[0] + v1[1] * v1[1]) + (v1[2] * v1[2] + v1[3] * v1[3]);
                    u32x4 w; w.x = cvt_pk_bf16(v0[0], v0[1]); w.y = cvt_pk_bf16(v0[2], v0[3]); w.z = cvt_pk_bf16(v1[0], v1[1]); w.w = cvt_pk_bf16(v1[2], v1[3]);
                    *(u32x4*)(XB + off + bj * HALF) = w; }
                ss += __shfl_xor(ss, 16); ss += __shfl_xor(ss, 32);
                if (fq == 0) PS[(size_t)row * nps + u.pn * 4 + wc] = ss;
                if (m & 1) asm volatile("" ::: "memory"); }
    }
};
struct EpiResOut {
    static constexpr bool PERM = true, AFTER_DRAIN = false, PRELOAD = false;
    const bf16_t* XB; float* out; int ldc;
    __device__ __forceinline__ void operator()(const f32x4 (&acc)[2][2][4][2], const Unit& u, int wr, int wc, int fr, int fq) const {
        const int row0 = u.pm * BM + wr * 64 + fr, col0 = u.pn * BM + wc * 32 + 8 * fq;
#pragma unroll
        for (int ai = 0; ai < 2; ++ai)
#pragma unroll
            for (int m = 0; m < 4; ++m) { const size_t off = (size_t)(row0 + ai * HALF + m * 16) * ldc + col0;
                u32x4 r[2];
#pragma unroll
                for (int bj = 0; bj < 2; ++bj) r[bj] = *(const u32x4*)(XB + off + bj * HALF);
#pragma unroll
                for (int bj = 0; bj < 2; ++bj) {
                    const f32x4 b0 = {__uint_as_float(r[bj].x << 16), __uint_as_float(r[bj].x & 0xffff0000u), __uint_as_float(r[bj].y << 16), __uint_as_float(r[bj].y & 0xffff0000u)};
                    const f32x4 b1 = {__uint_as_float(r[bj].z << 16), __uint_as_float(r[bj].z & 0xffff0000u), __uint_as_float(r[bj].w << 16), __uint_as_float(r[bj].w & 0xffff0000u)};
                    *(f32x4*)(out + off + bj * HALF) = b0 + acc[ai][bj][m][0]; *(f32x4*)(out + off + bj * HALF + 4) = b1 + acc[ai][bj][m][1]; }
                if (m & 1) asm volatile("" ::: "memory"); }
    }
};
struct EpiBf16RS {
    static constexpr bool PERM = true, AFTER_DRAIN = false, PRELOAD = false;
    bf16_t* O; int ldc; const float* RS;
    __device__ __forceinline__ void operator()(const f32x4 (&acc)[2][2][4][2], const Unit& u, int wr, int wc, int fr, int fq) const {
        const int row0 = u.pm * BM + wr * 64 + fr, col0 = u.pn * BM + wc * 32 + 8 * fq;
#pragma unroll
        for (int ai = 0; ai < 2; ++ai)
#pragma unroll
            for (int m = 0; m < 4; ++m) { const int row = row0 + ai * HALF + m * 16; bf16_t* rowp = O + (size_t)row * ldc + col0;
                const float rs = RS[row];
#pragma unroll
                for (int bj = 0; bj < 2; ++bj) { const f32x4 v0 = acc[ai][bj][m][0] * rs, v1 = acc[ai][bj][m][1] * rs;
                    u32x4 w; w.x = cvt_pk_bf16(v0[0], v0[1]); w.y = cvt_pk_bf16(v0[2], v0[3]); w.z = cvt_pk_bf16(v1[0], v1[1]); w.w = cvt_pk_bf16(v1[2], v1[3]);
                    *(u32x4*)(rowp + bj * HALF) = w; } }
    }
};

__host__ __device__ __forceinline__ int rope_slot(int d) { if (d < 32) return 32 * ((d & 15) >> 2) + 4 * (d >> 4) + (d & 3); const int g = (d - 32) >> 3; return 32 * (g / 3) + 8 * (1 + g % 3) + (d & 7); }
template <class Pol> struct EpiHeads {
    static constexpr bool PERM = true, AFTER_DRAIN = false, PRELOAD = false;
    bf16_t* T; float* kmean; const float* RS; PG8_LAS unsigned char* xl;
    __device__ __forceinline__ void operator()(const f32x4 (&acc)[2][2][4][2], const Unit& u, int wr, int wc, int fr, int fq) const {
#ifdef PROBE_KMAX
        const int kind = (Pol::TPB == 8 && !Pol::HAS_RS) ? min(Pol::kind(u.pn), (int)(size_t)RS) : Pol::kind(u.pn);
#else
        const int kind = Pol::kind(u.pn);
#endif
        const int b = u.pm / Pol::TPB, s0 = (u.pm % Pol::TPB) * BM;
        PG8_LAS float* P = (PG8_LAS float*)xl;
        PG8_LAS float* KS = (PG8_LAS float*)(xl + 8192);
#define EH_RSC(ai, m) (Pol::HAS_RS ? RS[u.pm * BM + (ai) * HALF + wr * 64 + (m) * 16 + fr] : 1.f)
        if (kind >= 1) {
#pragma unroll
            for (int ai = 0; ai < 2; ++ai)
#pragma unroll
                for (int m = 0; m < 4; ++m)
#pragma unroll
                    for (int bj = 0; bj < 2; ++bj) { const float rsc_ = EH_RSC(ai, m); const f32x4 a0 = acc[ai][bj][m][0] * rsc_, a1 = acc[ai][bj][m][1] * rsc_;
                        float ss = (a0[0] * a0[0] + a0[1] * a0[1]) + (a0[2] * a0[2] + a0[3] * a0[3]) + (a1[0] * a1[0] + a1[1] * a1[1]) + (a1[2] * a1[2] + a1[3] * a1[3]);
                        ss += __shfl_xor(ss, 16); ss += __shfl_xor(ss, 32);
                        if (fq == 0) P[(bj * BM + ai * HALF + wr * 64 + m * 16 + fr) * 4 + wc] = ss; }
            asm volatile("s_waitcnt lgkmcnt(0)" ::: "memory"); __builtin_amdgcn_s_barrier(); asm volatile("" ::: "memory");
        }
        const PG8_LAS float* g = (const PG8_LAS float*)(xl + 10240) + Pol::gain(u.pn) * 128;
        f32x4 gv0 = {1.f, 1.f, 1.f, 1.f}, gv1 = {1.f, 1.f, 1.f, 1.f};
        const int d0 = kind >= 2 ? (fq == 0 ? 4 * wc : 32 + 8 * (3 * wc + fq - 1)) : wc * 32 + 8 * fq, d1 = (kind >= 2 && fq == 0) ? 16 + 4 * wc : d0 + 4;
        if (kind >= 1) { const float qs = Pol::qscale(u.pn); gv0 = *(const PG8_LAS f32x4*)(g + d0) * qs; gv1 = *(const PG8_LAS f32x4*)(g + d1) * qs; }
        f32x4 cs[2][2];
#pragma unroll
        for (int bj = 0; bj < 2; ++bj) { cs[bj][0] = (f32x4){0.f, 0.f, 0.f, 0.f}; cs[bj][1] = (f32x4){0.f, 0.f, 0.f, 0.f}; }
#pragma unroll
        for (int ai = 0; ai < 2; ++ai)
#pragma unroll
            for (int m = 0; m < 4; ++m) { const int r = ai * HALF + wr * 64 + m * 16 + fr;
                f32x4 y[2][2];
#pragma unroll
                for (int bj = 0; bj < 2; ++bj) { float rs = EH_RSC(ai, m);
                    if (kind >= 1) { const f32x4 p = *(const PG8_LAS f32x4*)(P + (bj * BM + r) * 4); rs *= __builtin_amdgcn_rsqf(((p[0] + p[1]) + (p[2] + p[3])) * (1.f / 128.f) + 1e-6f); }
                    y[bj][0] = acc[ai][bj][m][0] * rs * gv0; y[bj][1] = acc[ai][bj][m][1] * rs * gv1; }
                if (kind >= 2) {
                    constexpr float KTH[4] = {1.000000000e+00f, 4.403666027e-01f, 1.939227447e-01f, 8.539710029e-02f};
                    const float arev = (float)(s0 + r) * (wc == 0 ? 0.15915494309f : wc == 1 ? 5.985185713e-03f : wc == 2 ? 2.250790790e-04f : 8.464330808e-06f);
                    f32x4 c0, sn0;
#pragma unroll
                    for (int e = 0; e < 4; ++e) { const float t0 = __builtin_amdgcn_fractf(arev * KTH[e]); c0[e] = __builtin_amdgcn_cosf(t0); sn0[e] = __builtin_amdgcn_sinf(t0); }
                    if (fq == 0) {
#pragma unroll
                        for (int bj = 0; bj < 2; ++bj) { const f32x4 x1 = y[bj][0], x2 = y[bj][1];
                            y[bj][0] = x1 * c0 - x2 * sn0; y[bj][1] = x2 * c0 + x1 * sn0; } }
                }
#pragma unroll
                for (int bj = 0; bj < 2; ++bj) {
                    if (kind == 3) { cs[bj][0] += y[bj][0]; cs[bj][1] += y[bj][1]; }
                    u32x4 w; w.x = cvt_pk_bf16(y[bj][0][0], y[bj][0][1]); w.y = cvt_pk_bf16(y[bj][0][2], y[bj][0][3]); w.z = cvt_pk_bf16(y[bj][1][0], y[bj][1][1]); w.w = cvt_pk_bf16(y[bj][1][2], y[bj][1][3]);
#ifdef PROBE_KMAX
                    if (kind >= 0)
#endif
                    { bf16_t* tp = T + ((size_t)((2 * u.pn + bj) * Pol::NB + b) * Pol::S + s0 + r) * 128;
                      if (kind >= 2) { *(unsigned long long*)(tp + d0) = (unsigned long long)w.x | ((unsigned long long)w.y << 32); *(unsigned long long*)(tp + d1) = (unsigned long long)w.z | ((unsigned long long)w.w << 32); }
                      else *(u32x4*)(tp + d0) = w; } }
                asm volatile("" ::: "memory");
            }
        if (kind == 3) {
#pragma unroll
            for (int bj = 0; bj < 2; ++bj)
#pragma unroll
                for (int n = 0; n < 2; ++n)
#pragma unroll
                    for (int e = 0; e < 4; ++e) { float v = cs[bj][n][e]; v += __shfl_xor(v, 1); v += __shfl_xor(v, 2); v += __shfl_xor(v, 4); v += __shfl_xor(v, 8); cs[bj][n][e] = v; }
            if (fr == 0) {
#pragma unroll
                for (int bj = 0; bj < 2; ++bj) { *(PG8_LAS f32x4*)(KS + wr * 256 + bj * HALF + d0) = cs[bj][0]; *(PG8_LAS f32x4*)(KS + wr * 256 + bj * HALF + d1) = cs[bj][1]; } }
            asm volatile("s_waitcnt lgkmcnt(0)" ::: "memory"); __builtin_amdgcn_s_barrier(); asm volatile("" ::: "memory");
            int t = threadIdx.x; asm volatile("" : "+v"(t));
            if (t < 256) { const int h = Pol::kmhead(u.pn) + (t >> 7);
                kmean[((size_t)(b * 16 + h) * 8 + (u.pm % Pol::TPB)) * 128 + (t & 127)] = (KS[t] + KS[256 + t]) * (1.f / 256.f); }
        }
    }
};
#undef EH_RSC
struct PolProj {
    static constexpr int TPB = 8, NB = 8, S = 2048; static constexpr bool HAS_RS = false;
    __device__ static __forceinline__ int kind(int pn) { return pn < 8 ? 2 : pn < 16 ? 3 : pn < 24 ? 0 : pn < 40 ? 2 : 0; }
    __device__ static __forceinline__ int gain(int pn) { return pn < 8 ? 0 : pn < 16 ? 1 : pn < 32 ? 2 : 3; }
    __device__ static __forceinline__ int kmhead(int pn) { return 2 * (pn - 8); }
    __device__ static __forceinline__ float qscale(int pn) { return (pn < 8 || (pn >= 24 && pn < 32)) ? 0.12751743074602325f : 1.f; }
};
struct PolQc {
    static constexpr int TPB = 8, NB = 8, S = 2048; static constexpr bool HAS_RS = true;
    __device__ static __forceinline__ float qscale(int) { return 0.12751743074602325f; }
    __device__ static __forceinline__ int kind(int) { return 1; }
    __device__ static __forceinline__ int gain(int) { return 0; }
    __device__ static __forceinline__ int kmhead(int) { return 0; }
};
struct PolKv {
    static constexpr int TPB = 1, NB = 8, S = 256; static constexpr bool HAS_RS = false;
    __device__ static __forceinline__ float qscale(int) { return 1.f; }
    __device__ static __forceinline__ int kind(int pn) { return pn < 2 ? 1 : 0; }
    __device__ static __forceinline__ int gain(int) { return 0; }
    __device__ static __forceinline__ int kmhead(int) { return 0; }
};

template <class Epi, class Sched, bool ALIGN_EPI = false, bool SP2 = false, bool KSPLIT = false>
__device__ __forceinline__ void gemm_phase(PG8_LAS unsigned char* lds, const Gemm g, const Sched& S, const Epi& E, const int tid_in = -1) {
    const int tid = tid_in < 0 ? (int)threadIdx.x : tid_in, wid = __builtin_amdgcn_readfirstlane(tid >> 6), lane = tid & 63, wr = wid >> 2, wc = wid & 3, fr = lane & 15, fq = lane >> 4;
    const int K = g.K, nt = K / BK;
    unsigned voffA[2], voffB[2];
#pragma unroll
    for (int i = 0; i < 2; ++i) { int R, C; stage_rc(tid * 16 + i * 8192, R, C); const int Rb = Epi::PERM ? ((R & ~31) + perm32(R & 31)) : R;
        voffA[i] = (unsigned)(R * K + C) * 2u; voffB[i] = (unsigned)(Rb * K + C) * 2u; }
    unsigned vA2[2], vB2[2];
#pragma unroll
    for (int h = 0; h < 2; ++h) { int R, C; stage_rc((2 * wid + h) * 1024 + lane * 16, R, C); const int Rb = Epi::PERM ? ((R & ~31) + perm32(R & 31)) : R;
        vA2[h] = (unsigned)(R * K + C) * 2u; vB2[h] = (unsigned)(Rb * K + C) * 2u; }
    const size_t kstep = (size_t)(BK * 2);
    const size_t hstep = (size_t)HALF * K * 2;
    const size_t tstep = 2 * hstep;
    const unsigned ldsw = (unsigned)wid * 1024u;
    const int aoff = lds_byte(wr * 64 + fr, fq * 8), boff = lds_byte(wc * 32 + fr, fq * 8);
#define PG8_SA(b, h) (((b) * 2 + (h)) * HTB)
#define PG8_SB(b, h) ((4 + (b) * 2 + (h)) * HTB)
#define PG8_STAGE(bufoff, gbase, voff) do { _Pragma("unroll") for (int _i = 0; _i < 2; ++_i) \
        __builtin_amdgcn_global_load_lds((const unsigned*)((const char*)(gbase) + (voff)[_i]), (PG8_LAS unsigned*)(lds + (bufoff) + ldsw + _i * 8192), 16, 0, 0); } while (0)
#define PG8_LDA(dst, b, h) do { _Pragma("unroll") for (int m = 0; m < 4; ++m) _Pragma("unroll") for (int k = 0; k < 2; ++k) dst[m][k] = *(const PG8_LAS bf16x8*)(lds + PG8_SA(b, h) + aoff + m * 2048 + k * 1024); } while (0)
#define PG8_LDB(dst, b, h) do { _Pragma("unroll") for (int n = 0; n < 2; ++n) _Pragma("unroll") for (int k = 0; k < 2; ++k) dst[n][k] = *(const PG8_LAS bf16x8*)(lds + PG8_SB(b, h) + boff + n * 2048 + k * 1024); } while (0)
#define PG8_MMA(ai, bj, At, Bt) do { __builtin_amdgcn_s_setprio(1); _Pragma("unroll") for (int m = 0; m < 4; ++m) _Pragma("unroll") for (int n = 0; n < 2; ++n) _Pragma("unroll") for (int k = 0; k < 2; ++k) \
        acc[ai][bj][m][n] = __builtin_amdgcn_mfma_f32_16x16x32_bf16(Bt[n][k], At[m][k], acc[ai][bj][m][n], 0, 0, 0); __builtin_amdgcn_s_setprio(0); } while (0)
#define PG8_STG1(bufoff, gbase, voffh, h) __builtin_amdgcn_global_load_lds((const unsigned*)((const char*)(gbase) + (voffh)), (PG8_LAS unsigned*)(lds + (bufoff) + (2 * wid + (h)) * 1024), 16, 0, 0)
#define PG8_STAGE_K(b, h, ap, bp) do { PG8_STG1(PG8_SA(b, 0), ap, vA2[h], h); PG8_STG1(PG8_SA(b, 1), (ap) + hstep, vA2[h], h); PG8_STG1(PG8_SB(b, 0), bp, vB2[h], h); PG8_STG1(PG8_SB(b, 1), (bp) + hstep, vB2[h], h); } while (0)
#define PG8_LDK(b, k) do { _Pragma("unroll") for (int ai = 0; ai < 2; ++ai) _Pragma("unroll") for (int m = 0; m < 4; ++m) Af[ai][m] = *(const PG8_LAS bf16x8*)(lds + PG8_SA(b, ai) + aoff + m * 2048 + (k) * 1024); \
        _Pragma("unroll") for (int bj = 0; bj < 2; ++bj) _Pragma("unroll") for (int n = 0; n < 2; ++n) Bf[bj][n] = *(const PG8_LAS bf16x8*)(lds + PG8_SB(b, bj) + boff + n * 2048 + (k) * 1024); } while (0)
#define PG8_MMK() do { __builtin_amdgcn_s_setprio(1); _Pragma("unroll") for (int ai = 0; ai < 2; ++ai) _Pragma("unroll") for (int bj = 0; bj < 2; ++bj) _Pragma("unroll") for (int m = 0; m < 4; ++m) _Pragma("unroll") for (int n = 0; n < 2; ++n) \
        acc[ai][bj][m][n] = __builtin_amdgcn_mfma_f32_16x16x32_bf16(Bf[bj][n], Af[ai][m], acc[ai][bj][m][n], 0, 0, 0); __builtin_amdgcn_s_setprio(0); } while (0)
#define PG8_WAIT_V(n) asm volatile("s_waitcnt vmcnt(" #n ")" ::: "memory")
#define PG8_WAIT_L(n) asm volatile("s_waitcnt lgkmcnt(" #n ")" ::: "memory")
#define PG8_BAR __builtin_amdgcn_s_barrier()
#define PG8_SCHED __builtin_amdgcn_sched_barrier(0)
    Unit cur, nxt; int ui = 0;
    if (!S.next(0, cur)) return;
    f32x4 acc[2][2][4][2];
#pragma unroll
    for (int a = 0; a < 2; ++a)
#pragma unroll
        for (int b = 0; b < 2; ++b)
#pragma unroll
            for (int m = 0; m < 4; ++m)
#pragma unroll
                for (int n = 0; n < 2; ++n) acc[a][b][m][n] = (f32x4){0.f, 0.f, 0.f, 0.f};
    bf16x8 At[4][2], B0[2][2], B1[2][2];
    bf16x8 Af[2][4], Bf[2][2];
    const char* cA = (const char*)g.A + (size_t)cur.pm * tstep; const char* cB = (const char*)g.Bt + (size_t)cur.pn * tstep;
    S.a_ready(cur);
    float pre[8]; if constexpr (Epi::PRELOAD) E.preload(pre, cur, wr, fr);
    if constexpr (KSPLIT) {
        PG8_STAGE_K(0, 0, cA, cB); PG8_STAGE_K(0, 1, cA, cB); PG8_STAGE_K(1, 0, cA + kstep, cB + kstep);
        if (wr == 1) PG8_BAR;
        PG8_WAIT_V(8); PG8_BAR;
        PG8_BAR;
    } else
    if constexpr (SP2) {
        PG8_STAGE(PG8_SB(0, 0), cB, voffB); PG8_STAGE(PG8_SB(0, 1), cB + hstep, voffB); PG8_STAGE(PG8_SA(0, 0), cA, voffA); PG8_STAGE(PG8_SA(0, 1), cA + hstep, voffA);
        if (wr == 1) PG8_BAR;
        PG8_WAIT_V(2); PG8_BAR;
        PG8_STAGE(PG8_SB(1, 0), cB + kstep, voffB); PG8_STAGE(PG8_SA(1, 0), cA + kstep, voffA); PG8_STAGE(PG8_SB(1, 1), cB + hstep + kstep, voffB);
        PG8_WAIT_V(6); PG8_BAR;
    } else {
        PG8_STAGE(PG8_SB(0, 0), cB, voffB); PG8_STAGE(PG8_SA(0, 0), cA, voffA); PG8_STAGE(PG8_SB(0, 1), cB + hstep, voffB); PG8_STAGE(PG8_SA(0, 1), cA + hstep, voffA);
        if (wr == 1) PG8_BAR;
        PG8_WAIT_V(4); PG8_BAR;
        PG8_STAGE(PG8_SB(1, 0), cB + kstep, voffB); PG8_STAGE(PG8_SA(1, 0), cA + kstep, voffA); PG8_STAGE(PG8_SB(1, 1), cB + hstep + kstep, voffB);
        PG8_WAIT_V(6); PG8_BAR;
    }
    for (;;) {
        const bool has_next = S.next(ui + 1, nxt);
        const char* nA = has_next ? (const char*)g.A + (size_t)nxt.pm * tstep : cA; const char* nB = has_next ? (const char*)g.Bt + (size_t)nxt.pn * tstep : cB;
        for (int t = 0; t < nt; t += 2) {
            const bool last = (t == nt - 2);
            const char* a1 = cA + (size_t)(t + 1) * kstep;
            const char* a2 = last ? nA : cA + (size_t)(t + 2) * kstep; const char* b2 = last ? nB : cB + (size_t)(t + 2) * kstep;
            const char* a3 = a2 + kstep; const char* b3 = b2 + kstep;
            if (last && has_next) S.a_ready(nxt);
            if constexpr (KSPLIT) {
            const char* b1 = cB + (size_t)(t + 1) * kstep;
            PG8_LDK(0, 0); PG8_STAGE_K(1, 1, a1, b1); PG8_WAIT_V(8); PG8_WAIT_L(0); PG8_BAR; PG8_MMK(); PG8_BAR; PG8_SCHED;
            PG8_LDK(0, 1); PG8_STAGE_K(0, 0, a2, b2); PG8_WAIT_V(8); PG8_WAIT_L(0); PG8_BAR; PG8_MMK(); PG8_BAR; PG8_SCHED;
            PG8_LDK(1, 0); PG8_STAGE_K(0, 1, a2, b2); PG8_WAIT_V(8); PG8_WAIT_L(0); PG8_BAR; PG8_MMK(); PG8_BAR; PG8_SCHED;
            PG8_LDK(1, 1); PG8_STAGE_K(1, 0, a3, b3); PG8_WAIT_V(8); PG8_WAIT_L(0); PG8_BAR; PG8_MMK(); PG8_BAR; PG8_SCHED;
            } else
            if constexpr (SP2) {
            PG8_LDB(B0, 0, 0); PG8_LDB(B1, 0, 1); PG8_SCHED; PG8_LDA(At, 0, 0); PG8_STAGE(PG8_SA(1, 1), a1 + hstep, voffA);
            PG8_WAIT_V(8); PG8_WAIT_L(0); PG8_BAR; PG8_MMA(0, 0, At, B0); PG8_MMA(0, 1, At, B1); PG8_BAR; PG8_SCHED;
            PG8_LDA(At, 0, 1); PG8_STAGE(PG8_SB(0, 0), b2, voffB); PG8_STAGE(PG8_SB(0, 1), b2 + hstep, voffB); PG8_STAGE(PG8_SA(0, 0), a2, voffA);
            PG8_WAIT_V(8); PG8_WAIT_L(0); PG8_BAR; PG8_MMA(1, 0, At, B0); PG8_MMA(1, 1, At, B1); PG8_BAR; PG8_SCHED;
            PG8_LDB(B0, 1, 0); PG8_LDB(B1, 1, 1); PG8_SCHED; PG8_LDA(At, 1, 0); PG8_STAGE(PG8_SA(0, 1), a2 + hstep, voffA);
            PG8_WAIT_V(8); PG8_WAIT_L(0); PG8_BAR; PG8_MMA(0, 0, At, B0); PG8_MMA(0, 1, At, B1); PG8_BAR; PG8_SCHED;
            PG8_LDA(At, 1, 1); PG8_STAGE(PG8_SB(1, 0), b3, voffB); PG8_STAGE(PG8_SB(1, 1), b3 + hstep, voffB); PG8_STAGE(PG8_SA(1, 0), a3, voffA);
            PG8_WAIT_V(8); PG8_WAIT_L(0); PG8_BAR; PG8_MMA(1, 0, At, B0); PG8_MMA(1, 1, At, B1); PG8_BAR; PG8_SCHED;
            } else {
            PG8_LDB(B0, 0, 0); PG8_SCHED; PG8_LDA(At, 0, 0); PG8_STAGE(PG8_SA(1, 1), a1 + hstep, voffA);
            PG8_WAIT_L(8); PG8_BAR; PG8_WAIT_L(0); PG8_MMA(0, 0, At, B0); PG8_BAR; PG8_SCHED;
            PG8_LDB(B1, 0, 1); PG8_STAGE(PG8_SB(0, 0), b2, voffB);
            PG8_BAR; PG8_WAIT_L(0); PG8_MMA(0, 1, At, B1); PG8_BAR;
            PG8_LDA(At, 0, 1); PG8_STAGE(PG8_SA(0, 0), a2, voffA);
            PG8_BAR; PG8_WAIT_L(0); PG8_MMA(1, 0, At, B0); PG8_BAR; PG8_SCHED;
            PG8_STAGE(PG8_SB(0, 1), b2 + hstep, voffB);
            PG8_WAIT_V(6); PG8_BAR; PG8_MMA(1, 1, At, B1); PG8_BAR;
            PG8_LDB(B0, 1, 0); PG8_SCHED; PG8_LDA(At, 1, 0); PG8_STAGE(PG8_SA(0, 1), a2 + hstep, voffA);
            PG8_WAIT_L(8); PG8_BAR; PG8_WAIT_L(0); PG8_MMA(0, 0, At, B0); PG8_BAR; PG8_SCHED;
            PG8_LDB(B1, 1, 1); PG8_STAGE(PG8_SB(1, 0), b3, voffB);
            PG8_BAR; PG8_WAIT_L(0); PG8_MMA(0, 1, At, B1); PG8_BAR;
            PG8_LDA(At, 1, 1); PG8_STAGE(PG8_SA(1, 0), a3, voffA);
            PG8_BAR; PG8_WAIT_L(0); PG8_MMA(1, 0, At, B0); PG8_BAR; PG8_SCHED;
            PG8_STAGE(PG8_SB(1, 1), b3 + hstep, voffB);
            PG8_WAIT_V(6); PG8_BAR; PG8_MMA(1, 1, At, B1); PG8_BAR;
            }
        }
        if constexpr (ALIGN_EPI) { if (wr == 0) PG8_BAR; }
        if constexpr (!Epi::AFTER_DRAIN) { if constexpr (Epi::PRELOAD) E(acc, cur, wr, wc, fr, fq, pre); else E(acc, cur, wr, wc, fr, fq); S.done(cur); }
        if (!has_next) break;
#pragma unroll
        for (int a = 0; a < 2; ++a)
#pragma unroll
            for (int b = 0; b < 2; ++b)
#pragma unroll
                for (int m = 0; m < 4; ++m)
#pragma unroll
                    for (int n = 0; n < 2; ++n) acc[a][b][m][n] = (f32x4){0.f, 0.f, 0.f, 0.f};
        cur = nxt; cA = nA; cB = nB; ++ui;
        if constexpr (Epi::PRELOAD) E.preload(pre, cur, wr, fr);
        if constexpr (ALIGN_EPI) { if (wr == 1) PG8_BAR; }
    }
    PG8_WAIT_V(0);
    if constexpr (!ALIGN_EPI) { if (wr == 0) PG8_BAR; }
    PG8_BAR;
    if constexpr (Epi::AFTER_DRAIN) { E.fused(acc, cur, wr, wc, fr, fq, lds, wid, lane); S.done(cur); }
#undef PG8_SA
#undef PG8_SB
#undef PG8_STAGE
#undef PG8_LDA
#undef PG8_LDB
#undef PG8_MMA
#undef PG8_STG1
#undef PG8_STAGE_K
#undef PG8_LDK
#undef PG8_MMK
#undef PG8_WAIT_V
#undef PG8_WAIT_L
#undef PG8_BAR
#undef PG8_SCHED
}
}

#ifndef PG8_KSPLIT
#define PG8_KSPLIT false
#endif
#ifndef PG8_SP2
#define PG8_SP2 true
#endif
#ifndef PG8_ALIGN
#define PG8_ALIGN true
#endif


namespace att {
typedef unsigned short bf16;
typedef short bf16x8 __attribute__((ext_vector_type(8)));
typedef short s16x4 __attribute__((ext_vector_type(4)));
typedef float f32x16 __attribute__((ext_vector_type(16)));
typedef float f32x4 __attribute__((ext_vector_type(4)));
typedef unsigned u32x4 __attribute__((ext_vector_type(4)));
constexpr int NW = 8, QBLK = 32, KVBLK = 64, QB = NW * QBLK, D = 128;
constexpr float SCALE = 0.08838834764831845f;
constexpr float THR = 8.f;
constexpr int SHM_V = KVBLK * D * 2, SHM_K = KVBLK * D * 2;
constexpr int NVB = 3;
constexpr int LDS_WS_OFF = NVB * SHM_V + 2 * SHM_K, LDS_KM_OFF = LDS_WS_OFF + NW * 64 * 4, LDS_BYTES = LDS_KM_OFF + 2 * 4096;
constexpr unsigned WBIG = 0x40000000u;

#define KSWZ(row, colB) ((row) * 256 + ((colB) ^ (((row) & 7) << 4)))
#define SBAR() __builtin_amdgcn_sched_barrier(0)
__device__ __forceinline__ int v_st(int k, int c) { const int kk = (k & ~0xC) | ((k & 4) << 1) | ((k & 8) >> 1); return ((kk >> 3) * 4 + (c >> 5)) * 512 + ((kk & 7) * 32 + (c & 31)) * 2; }
__device__ __forceinline__ int v_rd_base(int lane) { return ((lane & 3) << 3) | (((lane >> 2) & 3) << 6) | (((lane >> 4) & 1) << 5) | (((lane >> 5) & 1) << 8); }
constexpr int v_rd_off(int d0, int ks, int half) { return d0 * 512 + ks * 4096 + half * 2048; }
__device__ __forceinline__ int crow(int r, int hi) { return (r & 3) + 8 * (r >> 2) + 4 * hi; }
__device__ __forceinline__ unsigned cvtpk(float lo, float hi) { unsigned r; asm volatile("v_cvt_pk_bf16_f32 %0, %1, %2" : "=v"(r) : "v"(lo), "v"(hi)); return r; }
__device__ __forceinline__ bf16x8 load8(const bf16* p) { return *reinterpret_cast<const bf16x8*>(p); }
__device__ __forceinline__ void mask_tile(f32x16& p0, f32x16& p1, int dq, unsigned W) {
    const float NEG = -__builtin_inff();
#pragma unroll
    for (int r = 0; r < 16; ++r) {
        const int c = (r & 3) + 8 * (r >> 2);
        if ((unsigned)(dq - c) >= W) p0[r] = NEG;
        if ((unsigned)(dq - c - 32) >= W) p1[r] = NEG;
    }
}
__device__ __forceinline__ void mask_tile_post(f32x16& p0, f32x16& p1, int dq, unsigned W) {
    const float NEG = -__builtin_inff();
#pragma unroll
    for (int r = 0; r < 16; ++r) {
        const int c = (r & 3) + 8 * (r >> 2);
        if ((unsigned)(dq - c) >= W) p0[r] = 0.f;
        if ((unsigned)(dq - c - 32) >= W) p1[r] = NEG;
    }
}
__device__ __forceinline__ void partialSM(f32x16& p0, f32x16& p1, float& m_reg, float& mn, float& alpha) {
    float pmax = p0[0]; for (int r = 1; r < 16; ++r) pmax = fmaxf(pmax, p0[r]); for (int r = 0; r < 16; ++r) pmax = fmaxf(pmax, p1[r]);
    { auto rr = __builtin_amdgcn_permlane32_swap(__float_as_uint(pmax), __float_as_uint(pmax), false, false);
      pmax = fmaxf(__uint_as_float(rr[0]), __uint_as_float(rr[1])); }
    constexpr float C2 = 1.4426950408889634f * SCALE;
    if (__builtin_expect(__all((pmax - m_reg) * SCALE <= THR), 1)) { mn = m_reg; alpha = 1.f; }
    else { mn = fmaxf(m_reg, pmax); alpha = __builtin_amdgcn_exp2f((m_reg - mn) * C2); m_reg = mn; }
    const float mnL = -mn * C2;
    for (int r = 0; r < 16; ++r) p0[r] = fmaf(p0[r], C2, mnL); for (int r = 0; r < 16; ++r) p1[r] = fmaf(p1[r], C2, mnL);
    for (int r = 0; r < 16; ++r) p0[r] = __builtin_amdgcn_exp2f(p0[r]);
}
#ifndef ATT_FIXEDMAX
#define ATT_FIXEDMAX 1
#endif
__device__ __forceinline__ void partialSM_fixed(f32x16& p0, f32x16& p1) {
    for (int r = 0; r < 16; ++r) p0[r] = __builtin_amdgcn_exp2f(p0[r]);
}
__device__ __forceinline__ void finishSM(f32x16& p0, f32x16& p1, float alpha, float& l_reg, bf16x8& pa0, bf16x8& pa1, bf16x8& pa2, bf16x8& pa3) {
    for (int r = 0; r < 16; ++r) p1[r] = __builtin_amdgcn_exp2f(p1[r]);
    float ps = 0; for (int r = 0; r < 16; ++r) ps += p0[r]; for (int r = 0; r < 16; ++r) ps += p1[r];
    { auto rr = __builtin_amdgcn_permlane32_swap(__float_as_uint(ps), __float_as_uint(ps), false, false);
      ps = __uint_as_float(rr[0]) + __uint_as_float(rr[1]); }
    l_reg = l_reg * alpha + ps;
#define PK4(P, B_, OUT) do { unsigned a0 = cvtpk(P[B_+0], P[B_+1]), a1 = cvtpk(P[B_+2], P[B_+3]);                          \
        unsigned b0 = cvtpk(P[B_+4], P[B_+5]), b1 = cvtpk(P[B_+6], P[B_+7]);                                             \
        auto r0 = __builtin_amdgcn_permlane32_swap(a0, b0, false, false); auto r1 = __builtin_amdgcn_permlane32_swap(a1, b1, false, false); \
        u32x4 w = {r0[0], r1[0], r0[1], r1[1]}; OUT = *reinterpret_cast<bf16x8*>(&w); } while (0)
    PK4(p0, 0, pa0); PK4(p0, 8, pa1); PK4(p1, 0, pa2); PK4(p1, 8, pa3);
#undef PK4
}
template <int KB>
__device__ __forceinline__ void qkt(f32x16& p0, f32x16& p1, const char* K_lds, int r32, int hi, const bf16x8* qr, float cinit) {
#pragma unroll
    for (int r = 0; r < 16; ++r) { p0[r] = cinit; p1[r] = cinit; }
    const char* kb[4];
#pragma unroll
    for (int dd = 0; dd < 4; ++dd) kb[dd] = K_lds + KB * SHM_K + KSWZ(r32, (dd * 16 + hi * 8) * 2);
#pragma unroll
    for (int d0 = 0; d0 < 8; ++d0) { const char* a = kb[d0 & 3] + (d0 >> 2) * 128;
        bf16x8 b0 = *reinterpret_cast<const bf16x8*>(a);
        bf16x8 b1 = *reinterpret_cast<const bf16x8*>(a + 32 * 256);
        p0 = __builtin_amdgcn_mfma_f32_32x32x16_bf16(b0, qr[d0], p0, 0, 0, 0);
        p1 = __builtin_amdgcn_mfma_f32_32x32x16_bf16(b1, qr[d0], p1, 0, 0, 0); }
}
typedef short v4i16_t __attribute__((ext_vector_type(4)));
typedef __attribute__((address_space(3))) v4i16_t* lds_v4i16_ptr;
template <bool EXPS>
__device__ __forceinline__ void pv_tile(f32x16* o, int vb0, bf16x8 pa0, bf16x8 pa1, bf16x8 pa2, bf16x8 pa3, f32x16& px) {
    const __attribute__((address_space(3))) char* vp = (const __attribute__((address_space(3))) char*)(unsigned)vb0;
#define TRRD(off) __builtin_bit_cast(s16x4, __builtin_amdgcn_ds_read_tr16_b64_v4i16((lds_v4i16_ptr)(vp + (off))))
#define PV_RD(i, L, H) do { constexpr int o_ = v_rd_off((i) & 3, (i) >> 2, 0); L = TRRD(o_); H = TRRD(o_ + 2048); } while (0)
#define PV_PA(ks) ((ks) == 0 ? pa0 : (ks) == 1 ? pa1 : (ks) == 2 ? pa2 : pa3)
#define PV_STEP(i, L, H) do { o[(i) & 3] = __builtin_amdgcn_mfma_f32_32x32x16_bf16((bf16x8){L[0], L[1], L[2], L[3], H[0], H[1], H[2], H[3]}, PV_PA((i) >> 2), o[(i) & 3], 0, 0, 0);     \
        if ((i) + 4 < 16) PV_RD((i) + 4, L, H); if constexpr (EXPS) px[i] = __builtin_amdgcn_exp2f(px[i]); SBAR(); } while (0)
    s16x4 l0, h0, l1, h1, l2, h2, l3, h3;
    PV_RD(0, l0, h0); PV_RD(1, l1, h1); PV_RD(2, l2, h2); PV_RD(3, l3, h3); SBAR();
    PV_STEP(0, l0, h0); PV_STEP(1, l1, h1); PV_STEP(2, l2, h2); PV_STEP(3, l3, h3);
    PV_STEP(4, l0, h0); PV_STEP(5, l1, h1); PV_STEP(6, l2, h2); PV_STEP(7, l3, h3);
    PV_STEP(8, l0, h0); PV_STEP(9, l1, h1); PV_STEP(10, l2, h2); PV_STEP(11, l3, h3);
    PV_STEP(12, l0, h0); PV_STEP(13, l1, h1); PV_STEP(14, l2, h2); PV_STEP(15, l3, h3);
#undef PV_STEP
#undef PV_PA
#undef PV_RD
#undef TRRD
}

struct BlockRef { const bf16* Q; const bf16* K; const bf16* V; bf16* O; int P0, skv, moba_qb, kmi; float mnl; };
struct Seam { bf16x8 qr[8]; bf16x8 st_v0, st_v1, st_k0, st_k1; };
#define ROWP(p, k0, rr) ((p) + (size_t)((k0) + (rr)) * PKV + sc)
#define VMW() asm volatile("s_waitcnt vmcnt(0)" ::: "memory")
#define VMWN(n) asm volatile("s_waitcnt vmcnt(%0)" :: "i"(n) : "memory")
#define SLOAD_H(Kp, Vp, k0) do { S.st_v0 = load8(ROWP(Vp, k0, sr)); S.st_v1 = load8(ROWP(Vp, k0, 32 + sr));              \
                                 S.st_k0 = load8(ROWP(Kp, k0, sr)); S.st_k1 = load8(ROWP(Kp, k0, 32 + sr)); } while (0)
#define SWRITE_HK(bf) do { *(bf16x8*)(K_lds + (bf) * SHM_K + kws) = S.st_k0; *(bf16x8*)(K_lds + (bf) * SHM_K + kws + 32 * 256) = S.st_k1; } while (0)
#define SWRITE_HV(voff) do { *(bf16x8*)(V_lds + (voff) + vst0) = S.st_v0; *(bf16x8*)(V_lds + (voff) + vst1) = S.st_v1; } while (0)
#define SWRITE_H(kb, voff) do { SWRITE_HV(voff); SWRITE_HK(kb); } while (0)
template <int PQ, int PKV, int PO, bool MOBA>
__device__ __forceinline__ void attn_prime(const BlockRef& cur, char* lds, Seam& S) {
    const int tid = threadIdx.x, wid = __builtin_amdgcn_readfirstlane(tid >> 6), lane = tid & 63, r32 = lane & 31, hi = lane >> 5;
    const int sr = tid >> 4, sc = (tid & 15) * 8, kws = KSWZ(sr, sc * 2); char* K_lds = lds + NVB * SHM_V;
    for (int d0 = 0; d0 < 8; ++d0) S.qr[d0] = load8(cur.Q + (size_t)(wid * QBLK + r32) * PQ + d0 * 16 + hi * 8);
    SLOAD_H(cur.K, cur.V, 0);
    VMW(); SWRITE_HK(0);
    __syncthreads();
}
template <int PQ, int PKV, int PO, bool MOBA>
__device__ __forceinline__ void attn_block(const BlockRef& cur, const BlockRef& nxt, char* lds, Seam& S) {
    const int tid = threadIdx.x, wid = __builtin_amdgcn_readfirstlane(tid >> 6), lane = tid & 63, r32 = lane & 31, hi = lane >> 5;
    int j_hi = (cur.P0 + QB - 1) / KVBLK + 1; if (j_hi > cur.skv / KVBLK) j_hi = cur.skv / KVBLK;
    const int NT = j_hi;
    const int qlo = cur.P0 + wid * QBLK, qm = qlo + r32 - 4 * hi;
    const int qbm = MOBA ? cur.moba_qb : -1;
    char* V_lds = lds; char* K_lds = lds + NVB * SHM_V;
    float* ws = (float*)(lds + LDS_WS_OFF) + wid * 64; float* li_l = ws, * al_l = ws + 32;
    float m_reg = -1e30f, l_reg = 0; f32x16 o[4] = {};
    const int sr = tid >> 4, sc = (tid & 15) * 8, vst0 = v_st(sr, sc), vst1 = vst0 + 8192  , kws = KSWZ(sr, sc * 2);
    const int vb0 = (int)(uintptr_t)V_lds + v_rd_base(lane);
    const bf16* Kh = cur.K; const bf16* Vh = cur.V;
    unsigned sel = 0xffu;
    if (MOBA && qbm > 3) {
        const float* km = (const float*)(lds + LDS_KM_OFF) + cur.kmi * 1024 + hi * 8;
        const float NEGI = -__builtin_inff();
        float v1 = NEGI, v2 = NEGI, v3 = NEGI; unsigned b1 = 0u, b2 = 0u, b3 = 0u;
#pragma unroll 1
        for (int j = 0; j < qbm; ++j) {
            float a = 0.f;
#pragma unroll
            for (int d0 = 0; d0 < 8; ++d0) {
                const f32x4 k0 = *(const f32x4*)(km + j * 128 + d0 * 16), k1 = *(const f32x4*)(km + j * 128 + d0 * 16 + 4);
                const bf16x8 q = S.qr[d0];
#pragma unroll
                for (int e = 0; e < 4; ++e) { a = fmaf(__uint_as_float((unsigned)(unsigned short)q[e] << 16), k0[e], a); }
#pragma unroll
                for (int e = 0; e < 4; ++e) { a = fmaf(__uint_as_float((unsigned)(unsigned short)q[4 + e] << 16), k1[e], a); }
            }
            a += __shfl_xor(a, 32);
            const unsigned bj = 1u << j;
            const bool g1 = a > v1, g2 = a > v2, g3 = a > v3;
            v3 = g2 ? v2 : (g3 ? a : v3); b3 = g2 ? b2 : (g3 ? bj : b3);
            v2 = g1 ? v1 : (g2 ? a : v2); b2 = g1 ? b1 : (g2 ? bj : b2);
            v1 = g1 ? a : v1;             b1 = g1 ? bj : b1;
        }
        sel = b1 | b2 | b3;
    }
#if ATT_FIXEDMAX
#define PSM(P0_, P1_, mn_, al_) do { partialSM_fixed(P0_, P1_); al_ = 1.f; } while (0)
#define RESC(a) do { } while (0)
#else
#define PSM(P0_, P1_, mn_, al_) partialSM(P0_, P1_, m_reg, mn_, al_)
#define RESC(a) do { if (__any((a) < 1.f)) { if (hi == 0) al_l[r32] = (a); asm volatile("s_waitcnt lgkmcnt(0)" ::: "memory");              \
                     for (int d_ = 0; d_ < 4; ++d_) for (int r = 0; r < 16; ++r) o[d_][r] *= al_l[crow(r, hi)]; } } while (0)
#endif
#define KBASE(t) ((t) * KVBLK)
#define MASKT(P0_, P1_, t) do { const int kb_ = KBASE(t); if (kb_ + KVBLK - 1 > qlo) mask_tile(P0_, P1_, qm - kb_, WBIG); } while (0)
#define CINIT(t) (((MOBA && ((t) >> 2) < qbm && !((sel >> ((t) >> 2)) & 1u)) ? -__builtin_inff() : 0.f) + (ATT_FIXEDMAX ? cur.mnl : 0.f))
    constexpr int NQL = 8;
#define SEAM_K0() do { VMWN(NQL); SWRITE_HK(0); SBAR(); } while (0)
    f32x16 pA0, pA1, pB0, pB1; float mnA, mnB, alA, alB; bf16x8 pa0, pa1, pa2, pa3;
    SWRITE_HV(0); SBAR();
    if (NT > 1) { SLOAD_H(Kh, Vh, KBASE(1)); }
    SBAR(); qkt<0>(pA0, pA1, K_lds, r32, hi, S.qr, CINIT(0));
    MASKT(pA0, pA1, 0); PSM(pA0, pA1, mnA, alA);
    if (NT > 1) { VMW(); SWRITE_H(1, SHM_V); }
    __syncthreads();
    int vA = 0, vB = SHM_V, vC = 2 * SHM_V;
#define HALF_STEP(PX0, PX1, mnX, alX, PY0, PY1, alY, t, KB, SB) do {                                                             \
        SBAR(); if ((t) + 1 < NT) { SLOAD_H(Kh, Vh, KBASE((t) + 1)); SBAR(); }     \
        qkt<KB>(PX0, PX1, K_lds, r32, hi, S.qr, CINIT(t));                                                                    \
        finishSM(PY0, PY1, alY, l_reg, pa0, pa1, pa2, pa3); SBAR();                                                           \
        pv_tile<ATT_FIXEDMAX != 0>(o, vb0 + vA, pa0, pa1, pa2, pa3, PX0);     \
        if (ATT_FIXEDMAX) { const int kb_ = KBASE(t); if (kb_ + KVBLK - 1 > qlo) mask_tile_post(PX0, PX1, qm - kb_, WBIG); alX = 1.f; } else { MASKT(PX0, PX1, (t)); PSM(PX0, PX1, mnX, alX); }   \
          \
        if ((t) + 1 < NT) { VMW(); SWRITE_H(SB, vC); }                                                                        \
        RESC(alX); { const int v_ = vA; vA = vB; vB = vC; vC = v_; } __syncthreads(); } while (0)
    for (int t = 1; t + 1 < NT; t += 2) {
        HALF_STEP(pB0, pB1, mnB, alB, pA0, pA1, alA, t, 1, 0);
        HALF_STEP(pA0, pA1, mnA, alA, pB0, pB1, alB, t + 1, 0, 1);
    }
    const bool even = (NT & 1) == 0;
    if (even) { SBAR(); qkt<1>(pB0, pB1, K_lds, r32, hi, S.qr, CINIT(NT - 1)); SBAR(); }
    SLOAD_H(nxt.K, nxt.V, 0); SBAR();
#pragma unroll
    for (int d0 = 0; d0 < 8; ++d0) S.qr[d0] = load8(nxt.Q + (size_t)(wid * QBLK + r32) * PQ + d0 * 16 + hi * 8);
    SBAR();
    finishSM(pA0, pA1, alA, l_reg, pa0, pa1, pa2, pa3); SBAR();
    pv_tile<false>(o, vb0 + vA, pa0, pa1, pa2, pa3, pA0);
    if (even) { MASKT(pB0, pB1, NT - 1); PSM(pB0, pB1, mnB, alB); __syncthreads(); RESC(alB);
        finishSM(pB0, pB1, alB, l_reg, pa0, pa1, pa2, pa3); SBAR(); pv_tile<false>(o, vb0 + vB, pa0, pa1, pa2, pa3, pB0); }
    SBAR(); SEAM_K0();
    const float rl_ = __builtin_amdgcn_rcpf(l_reg);
    int wq_ = wid; asm volatile("" : "+s"(wq_));
    unsigned loff_ = (unsigned)(r32 * PO) * 2u + (unsigned)hi * 16u; asm volatile("" : "+v"(loff_));
    char* Ob = (char*)(cur.O + (size_t)(wq_ * QBLK) * PO);
#pragma unroll
    for (int d0 = 0; d0 < 4; ++d0)
#pragma unroll
        for (int g = 0; g < 4; g += 2) {
            unsigned ax = cvtpk(o[d0][4 * g] * rl_, o[d0][4 * g + 1] * rl_), ay = cvtpk(o[d0][4 * g + 2] * rl_, o[d0][4 * g + 3] * rl_);
            unsigned bx = cvtpk(o[d0][4 * g + 4] * rl_, o[d0][4 * g + 5] * rl_), by = cvtpk(o[d0][4 * g + 6] * rl_, o[d0][4 * g + 7] * rl_);
            { auto r0 = __builtin_amdgcn_permlane32_swap(ax, bx, false, false); ax = r0[0]; bx = r0[1]; }
            { auto r1 = __builtin_amdgcn_permlane32_swap(ay, by, false, false); ay = r1[0]; by = r1[1]; }
            u32x4 w = {ax, ay, bx, by};
            *(u32x4*)(Ob + (d0 * 32 + 8 * g) * 2 + loff_) = w; }
    __syncthreads();
#undef RESC
#undef PSM
#undef KBASE
#undef MASKT
#undef CINIT
#undef SEAM_K0
#undef HALF_STEP
}
#undef ROWP
#undef VMW
#undef VMWN
#undef SLOAD_H
#undef SWRITE_HK
#undef SWRITE_HV
#undef SWRITE_H
#undef KSWZ
#undef SBAR
}

#define GAS __attribute__((address_space(1)))
#define LAS __attribute__((address_space(3)))
typedef unsigned short bf16;
typedef unsigned v4u __attribute__((ext_vector_type(4)));
typedef float f32x4 __attribute__((ext_vector_type(4)));
typedef short bf16x8 __attribute__((ext_vector_type(8)));
typedef GAS unsigned gu32;
typedef GAS unsigned long long gu64;
#define RLX_AGENT __ATOMIC_RELAXED, __HIP_MEMORY_SCOPE_AGENT
#define LDS_WAIT() asm volatile("s_waitcnt lgkmcnt(0)" ::: "memory")
#define VM_WAIT() asm volatile("s_waitcnt vmcnt(0)" ::: "memory")
__device__ __forceinline__ unsigned long long rt() { return __builtin_amdgcn_s_memrealtime(); }
__device__ __forceinline__ unsigned f2bf(float f) { unsigned u = __builtin_bit_cast(unsigned, f); return (u + 0x7fffu + ((u >> 16) & 1u)) >> 16; }
__device__ __forceinline__ unsigned pk2(float lo, float hi) { return f2bf(lo) | (f2bf(hi) << 16); }

#define XB_TMO      128
#define XB_XCNT(j)  (256  + 64 * (j))
#define XB_XSUB(j)  (1280 + 64 * (j))
#define XB_XGEN(j)  (2304 + 64 * (j))
#define XB_TOP      3328
#define XB_TOPGEN   3392
#define XCD_BAR_WORDS 3456
#define XB_SPIN_CAP (1u << 18)

__device__ __forceinline__ unsigned xb_ld(unsigned* p)              { return __hip_atomic_load(p, __ATOMIC_RELAXED, __HIP_MEMORY_SCOPE_AGENT); }
__device__ __forceinline__ unsigned xb_add(unsigned* p, unsigned v) { return __hip_atomic_fetch_add(p, v, __ATOMIC_RELAXED, __HIP_MEMORY_SCOPE_AGENT); }
__device__ __forceinline__ unsigned xb_xcc_id() { return (unsigned)__builtin_amdgcn_s_getreg((3 << 11) | 20) & 0xFu; }
#define XB_SPIN(cond, bar) do { unsigned _sp = 0; while (cond) { __builtin_amdgcn_s_sleep(1); \
    if ((++_sp & 255u) == 0u) { if (xb_ld(&(bar)[XB_TMO])) break; if (_sp > XB_SPIN_CAP) { atomicAdd(&(bar)[XB_TMO], 1u); break; } } } } while (0)

struct XcdBarrier {
    unsigned* bar; unsigned x;
    volatile LAS unsigned* st;
};

__device__ __forceinline__ XcdBarrier xcd_barrier_post(unsigned* bar, volatile LAS unsigned* st) {
    XcdBarrier b; b.bar = bar; b.x = xb_xcc_id(); b.st = st;
    if (threadIdx.x == 0) (void)xb_add(&bar[XB_XCNT(b.x)], 1u);
    return b;
}
__device__ __forceinline__ void xcd_barrier_complete(unsigned* bar, unsigned x, unsigned& nloc, unsigned& nx) {
    const unsigned G = gridDim.x * gridDim.y * gridDim.z;
    unsigned sum, cnt, mine, sp = 0u;
    for (;;) {
        sum = 0u; cnt = 0u; mine = 0u;
#pragma unroll
        for (unsigned j = 0; j < 16; ++j) { const unsigned c = xb_ld(&bar[XB_XCNT(j)]); sum += c; cnt += (c > 0u) ? 1u : 0u; mine = (j == x) ? c : mine; }
        if (sum == G) break;
        __builtin_amdgcn_s_sleep(1);
        if ((++sp & 255u) == 0u) { if (xb_ld(&bar[XB_TMO])) break; if (sp > XB_SPIN_CAP) { atomicAdd(&bar[XB_TMO], 1u); break; } }
    }
    nloc = mine > 0u ? mine : 1u; nx = cnt > 0u ? cnt : 1u;
}

__device__ __forceinline__ void xcd_barrier(const XcdBarrier& b) {
    asm volatile("s_waitcnt vmcnt(0)" ::: "memory");
    __syncthreads();
    if (threadIdx.x == 0) {
        unsigned* bar = b.bar;
        __builtin_amdgcn_s_waitcnt(0);
        unsigned nloc = b.st[0], nx = b.st[1];
        if (nloc == 0u) { xcd_barrier_complete(bar, b.x, nloc, nx); b.st[0] = nloc; b.st[1] = nx; }
        const unsigned old = xb_add(&bar[XB_XSUB(b.x)], 1u);
        const unsigned gen = old / nloc;
        if (old + 1u == (gen + 1u) * nloc) {
            __builtin_amdgcn_fence(__ATOMIC_RELEASE, "agent");
            asm volatile("s_waitcnt vmcnt(0)" ::: "memory");
            const unsigned og = xb_add(&bar[XB_TOP], 1u);
            const unsigned tg = og / nx;
            if (og + 1u == (tg + 1u) * nx) xb_add(&bar[XB_TOPGEN], 1u);
            else XB_SPIN(xb_ld(&bar[XB_TOPGEN]) == tg, bar);
            __builtin_amdgcn_fence(__ATOMIC_ACQUIRE, "agent");
            xb_add(&bar[XB_XGEN(b.x)], 1u);
            asm volatile("s_waitcnt vmcnt(0)" ::: "memory");
        } else {
            XB_SPIN(xb_ld(&bar[XB_XGEN(b.x)]) == gen, bar);
            __builtin_amdgcn_fence(__ATOMIC_ACQUIRE, "agent");
            asm volatile("s_waitcnt vmcnt(0)" ::: "memory");
        }
    }
    __syncthreads();
}


constexpr int NWAVES = 8;
#ifndef MK_N_LAUNCHES
#define MK_N_LAUNCHES 1
#endif
constexpr int NPH = 14;
constexpr int N_LAUNCHES = MK_N_LAUNCHES;
static_assert(N_LAUNCHES == 1 || N_LAUNCHES == NPH, "MK_N_LAUNCHES is 1 or NPH");

constexpr int BATCH = 8, SEQ = 2048, DM = 4096, M = BATCH * SEQ;
constexpr int NIN = 12288, FF = 11008, NGU = 2 * FF, MEML = 256, MM = BATCH * MEML, MW = 512, NKV = 2 * MW;
constexpr int C_QA = 0, C_KA = 2048, C_VA = 4096, C_QB = 6144, C_KB = 8192, C_VB = 10240;
constexpr float NORM_EPS = 1e-6f;
constexpr float LAM_INIT = 0.2f;

constexpr size_t MiB = 1u << 20;
constexpr size_t WS_CTL = 0, CTL_ZERO_BYTES = 64 * 1024;
constexpr size_t WS_ROPE = 1 * MiB;
constexpr size_t WS_KMEAN = WS_ROPE + 512 * 1024;
constexpr size_t WS_W_IN = 2 * MiB;
constexpr size_t WS_W_OUT = WS_W_IN + (size_t)NIN * DM * 2;
constexpr size_t WS_W_MQ = WS_W_OUT + (size_t)DM * DM * 2;
constexpr size_t WS_W_MKV = WS_W_MQ + (size_t)MW * DM * 2;
constexpr size_t WS_W_MO = WS_W_MKV + (size_t)NKV * DM * 2;
constexpr size_t WS_W_GU = WS_W_MO + (size_t)DM * MW * 2;
constexpr size_t WS_W_DN = WS_W_GU + (size_t)NGU * DM * 2;
constexpr size_t WS_XN = WS_W_DN + (size_t)DM * FF * 2;
constexpr size_t WS_PROJ = WS_XN + (size_t)M * DM * 2;
constexpr size_t WS_MIX = WS_PROJ + (size_t)M * NIN * 2;
constexpr size_t WS_MEMN = WS_MIX + (size_t)M * DM * 2;
constexpr size_t WS_KVC = WS_MEMN + (size_t)MM * DM * 2;
constexpr size_t WS_PS = WS_KVC + (size_t)MM * NKV * 2;
constexpr size_t WS_RS = WS_PS + (size_t)2 * M * 64 * 4;
constexpr size_t WS_END = WS_RS + (size_t)2 * M * 4;
static_assert(WS_W_IN % MiB == 0 && WS_XN % 256 == 0 && WS_END <= 1140000000ull, "d_ws map");
constexpr int CW_TMO = 0, CW_CODE = 1;
constexpr int CW_BAR = 4096;
static_assert((CW_BAR + 2 * XCD_BAR_WORDS) * 4 <= (int)CTL_ZERO_BYTES, "both barrier regions inside the per-call memset");

constexpr int RING_OFF = 0, RING_BYTES = 131072;
constexpr int LDSCTL_OFF = RING_BYTES, MISC_OFF = LDSCTL_OFF + 320;
constexpr int EPIX_OFF = MISC_OFF + 128;
constexpr int LDS_BYTES = 147456;
static_assert(EPIX_OFF % 16 == 0 && EPIX_OFF + 12288 <= LDS_BYTES && att::LDS_BYTES <= RING_BYTES, "LDS map");

__device__ __forceinline__ float wave_sum(float v) {
#pragma unroll
    for (int o = 1; o < 64; o <<= 1) v += __shfl_xor(v, o);
    return v;
}
__device__ __forceinline__ float bf2f(unsigned short s) { return __uint_as_float((unsigned)s << 16); }
__device__ __forceinline__ void p0_transpose_item(const float* W, int K, int N, bf16* WT, int k0, int n0, int orow0, LAS float* scr, int lane, const float* gk = nullptr, bool pd = false) {
    const int lr = lane >> 4, n4 = lane & 15;
    f32x4 v[16];
#pragma unroll
    for (int i = 0; i < 16; ++i) v[i] = *(const GAS f32x4*)(W + (size_t)(k0 + 4 * i + lr) * N + n0 + 4 * n4);
    const int c = lane & 7, nn = lane >> 3;
    f32x4 ga = {1.f, 1.f, 1.f, 1.f}, gb = {1.f, 1.f, 1.f, 1.f};
    if (gk) { ga = *(const f32x4*)(gk + k0 + 8 * c); gb = *(const f32x4*)(gk + k0 + 8 * c + 4); }
#pragma unroll
    for (int i = 0; i < 16; ++i) { const int k = 4 * i + lr; *(LAS f32x4*)(scr + k * 64 + ((4 * n4) ^ (((k >> 3) & 7) << 2))) = v[i]; }
    LDS_WAIT(); asm volatile("" ::: "memory");
#pragma unroll
    for (int j = 0; j < 8; ++j) { const int n = nn + 8 * j; const LAS float* s = scr + (8 * c) * 64 + (n ^ (c << 2));
        v4u o; o.x = pk2(s[0 * 64] * ga.x, s[1 * 64] * ga.y); o.y = pk2(s[2 * 64] * ga.z, s[3 * 64] * ga.w); o.z = pk2(s[4 * 64] * gb.x, s[5 * 64] * gb.y); o.w = pk2(s[6 * 64] * gb.z, s[7 * 64] * gb.w);
        const int orow = pd ? ((orow0 + n) & ~127) + pg8::rope_slot((orow0 + n) & 127) : orow0 + n;
        *(GAS v4u*)(WT + (size_t)orow * K + k0 + 8 * c) = o; }
    LDS_WAIT(); asm volatile("" ::: "memory");
}
__device__ __forceinline__ void rms_row_to_bf16(const float* xrow, const float* g, bf16* orow, int lane) {
    const GAS f32x4* xr = (const GAS f32x4*)xrow + lane; const GAS f32x4* gr = (const GAS f32x4*)g + lane;
    f32x4 v[16]; float s = 0.f;
#pragma unroll
    for (int j = 0; j < 16; ++j) { v[j] = xr[64 * j]; s += (v[j].x * v[j].x + v[j].y * v[j].y) + (v[j].z * v[j].z + v[j].w * v[j].w); }
    const float rs = 1.0f / sqrtf(wave_sum(s) * (1.f / DM) + NORM_EPS);
    GAS unsigned long long* o8 = (GAS unsigned long long*)orow + lane;
#pragma unroll
    for (int j = 0; j < 16; ++j) { const f32x4 gg = gr[64 * j];
        o8[64 * j] = (unsigned long long)pk2(v[j].x * rs * gg.x, v[j].y * rs * gg.y) | ((unsigned long long)pk2(v[j].z * rs * gg.z, v[j].w * rs * gg.w) << 32); }
}
__device__ __forceinline__ void normrope_unit(bf16* T, int pitch, int row0, int c0, const float* g, const float* rope, float* km, LAS float* scr, int tid) {
    const int wave = tid >> 6, lane = tid & 63, rsub = lane >> 4, c = lane & 15;
    float gv[8];
    { const f32x4 g0 = *(const f32x4*)(g + 8 * c), g1 = *(const f32x4*)(g + 8 * c + 4); gv[0] = g0.x; gv[1] = g0.y; gv[2] = g0.z; gv[3] = g0.w; gv[4] = g1.x; gv[5] = g1.y; gv[6] = g1.z; gv[7] = g1.w; }
    float csum[8];
#pragma unroll
    for (int e = 0; e < 8; ++e) csum[e] = 0.f;
#pragma unroll 2
    for (int it = 0; it < 8; ++it) {
        const int r = row0 + wave * 32 + it * 4 + rsub;
        bf16* p = T + (size_t)r * pitch + c0 + 8 * c;
        const v4u raw = *(const v4u*)p;
        float y[8];
        y[0] = __uint_as_float(raw.x << 16); y[1] = __uint_as_float(raw.x & 0xffff0000u); y[2] = __uint_as_float(raw.y << 16); y[3] = __uint_as_float(raw.y & 0xffff0000u);
        y[4] = __uint_as_float(raw.z << 16); y[5] = __uint_as_float(raw.z & 0xffff0000u); y[6] = __uint_as_float(raw.w << 16); y[7] = __uint_as_float(raw.w & 0xffff0000u);
        float ss = 0.f;
#pragma unroll
        for (int e = 0; e < 8; ++e) ss += y[e] * y[e];
        ss += __shfl_xor(ss, 1); ss += __shfl_xor(ss, 2); ss += __shfl_xor(ss, 4); ss += __shfl_xor(ss, 8);
        const float rs = 1.0f / sqrtf(ss * (1.f / 128.f) + NORM_EPS);
#pragma unroll
        for (int e = 0; e < 8; ++e) y[e] = y[e] * rs * gv[e];
        if (rope) {
            float pr[8];
#pragma unroll
            for (int e = 0; e < 8; ++e) pr[e] = __shfl_xor(y[e], 2);
            if (c < 4) {
                const float* cs = rope + (size_t)(r & (SEQ - 1)) * 32 + (c & 1) * 8;
                const f32x4 c0v = *(const f32x4*)cs, c1v = *(const f32x4*)(cs + 4), s0v = *(const f32x4*)(cs + 16), s1v = *(const f32x4*)(cs + 20);
                const float cc[8] = {c0v.x, c0v.y, c0v.z, c0v.w, c1v.x, c1v.y, c1v.z, c1v.w}, sn[8] = {s0v.x, s0v.y, s0v.z, s0v.w, s1v.x, s1v.y, s1v.z, s1v.w};
                const float sg = (c < 2) ? -1.f : 1.f;
#pragma unroll
                for (int e = 0; e < 8; ++e) y[e] = y[e] * cc[e] + sg * pr[e] * sn[e];
            }
        }
#pragma unroll
        for (int e = 0; e < 8; ++e) csum[e] += y[e];
        v4u o; o.x = pk2(y[0], y[1]); o.y = pk2(y[2], y[3]); o.z = pk2(y[4], y[5]); o.w = pk2(y[6], y[7]);
        *(v4u*)p = o;
    }
    if (km) {
#pragma unroll
        for (int e = 0; e < 8; ++e) { csum[e] += __shfl_xor(csum[e], 16); csum[e] += __shfl_xor(csum[e], 32); }
        if (rsub == 0) {
#pragma unroll
            for (int e = 0; e < 8; ++e) scr[wave * 128 + 8 * c + e] = csum[e]; }
        __syncthreads();
        if (tid < 128) { float s = 0.f;
#pragma unroll
            for (int w = 0; w < 8; ++w) s += scr[w * 128 + tid];
            km[tid] = s * (1.f / 256.f); }
        __syncthreads();
    }
}


__device__ __forceinline__ bf16* hm_addr(bf16* T, int ch, int b, int s) { return T + ((size_t)(ch * BATCH + b) * SEQ + s) * 128; }
__device__ __forceinline__ float att_mnl(const float* gq, const float* gk, int lane) {
    float a = fmaxf(fabsf(gq[lane]), fabsf(gq[lane + 64])), b = fmaxf(fabsf(gk[lane]), fabsf(gk[lane + 64]));
#pragma unroll
    for (int o = 1; o < 64; o <<= 1) { a = fmaxf(a, __shfl_xor(a, o)); b = fmaxf(b, __shfl_xor(b, o)); }
    return __int_as_float(__builtin_amdgcn_readfirstlane(__float_as_int(-(128.0f * a * b * 1.03f) * (1.4426950408889634f * att::SCALE))));
}
__device__ __forceinline__ att::BlockRef attn_get(int idx, int G, int vcu, bf16* PROJ_, bf16* MIX_, bf16* DO_, float mnl_diff, float mnl_moba) {
    att::BlockRef r;
    if (idx < 8) { const int b = vcu >> 5, dh = (vcu >> 2) & 7, xq = vcu & 3, pass = idx >> 2, sub = idx & 3, s = sub >> 1, vh = (sub & 1) ^ s, qb = pass ? 7 - xq : xq;
        const size_t rq = (size_t)b * SEQ + (size_t)qb * 256;
        r.Q = hm_addr(PROJ_, 48 + 2 * dh + s, b, qb * 256); r.K = hm_addr(PROJ_, 64 + 2 * dh + s, b, 0); r.V = hm_addr(PROJ_, 80 + 2 * dh + vh, b, 0);
        r.O = DO_ + rq * DM + dh * 512 + s * 256 + vh * 128; r.moba_qb = -1; r.kmi = 0; r.P0 = qb * 256; r.mnl = mnl_diff; }
    else { const int mi = (idx - 8) >> 1, pass = idx & 1, I = mi * G + vcu, xq = I & 3, hm = I >> 2, b = hm >> 4, hu = hm & 15, qb = pass ? 7 - xq : xq;
        const size_t rq = (size_t)b * SEQ + (size_t)qb * 256;
        r.Q = hm_addr(PROJ_, hu, b, qb * 256); r.K = hm_addr(PROJ_, 16 + hu, b, 0); r.V = hm_addr(PROJ_, 32 + hu, b, 0); r.O = MIX_ + rq * DM + hu * 128;
        r.moba_qb = qb; r.kmi = mi; r.P0 = qb * 256; r.mnl = mnl_moba; }
    r.skv = SEQ;
    return r;
}

struct Args { const float* in[26]; float* out; float* outw; unsigned char* ws; int ph_lo, ph_hi, li, pad; };
#define KAS __attribute__((address_space(4)))
__device__ __forceinline__ const KAS Args* kargs() { const KAS Args* p = (const KAS Args*)__builtin_amdgcn_kernarg_segment_ptr(); asm volatile("" : "+s"(p)); return p; }
#define KARGS (kargs())
#define A_IN(k) (KARGS->in[k])
#define PS_CROSS ((float*)(ws + WS_PS))
#define PS_FFN ((float*)(ws + WS_PS) + (size_t)M * 64)
#define RS_CROSS ((float*)(ws + WS_RS))
#define RS_FFN ((float*)(ws + WS_RS) + M)
#define ROPE ((float*)(ws + WS_ROPE))
#define KMEAN ((float*)(ws + WS_KMEAN))
#define W_IN ((bf16*)(ws + WS_W_IN))
#define W_OUT ((bf16*)(ws + WS_W_OUT))
#define W_MQ ((bf16*)(ws + WS_W_MQ))
#define W_MKV ((bf16*)(ws + WS_W_MKV))
#define W_MO ((bf16*)(ws + WS_W_MO))
#define W_GU ((bf16*)(ws + WS_W_GU))
#define W_DN ((bf16*)(ws + WS_W_DN))
#define XN ((bf16*)(ws + WS_XN))
#define PROJ ((bf16*)(ws + WS_PROJ))
#define MIX ((bf16*)(ws + WS_MIX))
#define MEMN ((bf16*)(ws + WS_MEMN))
#define KVC ((bf16*)(ws + WS_KVC))
#define DO XN
#define HB PROJ
#define QC MIX
#define OC (MIX + (size_t)16 * MiB / 2)

constexpr int CV_I_IN = (DM / 64) * (NIN / 64), CV_I_OUT = (DM / 64) * (DM / 64), CV_I_MQ = (DM / 64) * (MW / 64), CV_I_MO = (MW / 64) * (DM / 64), CV_I_G = (DM / 64) * (FF / 64), CV_I_DN = (FF / 64) * (DM / 64);
constexpr int CV_S_GU = CV_I_IN + CV_I_OUT + 3 * CV_I_MQ + CV_I_MO, CV_S_DN = CV_S_GU + 2 * CV_I_G, CV_NITEMS = CV_S_DN + CV_I_DN;
constexpr int CV_GU_P7 = 96 * 8 * 9, CV_DN_P12 = 128 * 8 * 10;
constexpr int CV_P0_A = CV_S_DN - CV_GU_P7, CV_DN_P0 = CV_I_DN - CV_DN_P12;
static_assert(CV_P0_A > CV_S_GU && CV_DN_P0 >= 0, "conversion split");
__device__ __forceinline__ void convert_item(int it, unsigned char* ws, LAS float* scr, int lane) {
    int r = it;
    if (r < CV_I_IN) { const int nb = NIN / 64, kb = r / nb, n0 = 64 * (r % nb); p0_transpose_item(A_IN(3), DM, NIN, W_IN, 64 * kb, n0, n0, scr, lane, nullptr, pg8::PolProj::kind(n0 >> 8) >= 2); return; } r -= CV_I_IN;
    if (r < CV_I_OUT) { const int nb = DM / 64, kb = r / nb, n0 = 64 * (r % nb); p0_transpose_item(A_IN(13), DM, DM, W_OUT, 64 * kb, n0, n0, scr, lane); return; } r -= CV_I_OUT;
    if (r < CV_I_MQ) { const int nb = MW / 64, kb = r / nb, n0 = 64 * (r % nb); p0_transpose_item(A_IN(16), DM, MW, W_MQ, 64 * kb, n0, n0, scr, lane, A_IN(14)); return; } r -= CV_I_MQ;
    if (r < CV_I_MQ) { const int nb = MW / 64, kb = r / nb, n0 = 64 * (r % nb); p0_transpose_item(A_IN(17), DM, MW, W_MKV, 64 * kb, n0, n0, scr, lane); return; } r -= CV_I_MQ;
    if (r < CV_I_MQ) { const int nb = MW / 64, kb = r / nb, n0 = 64 * (r % nb); p0_transpose_item(A_IN(18), DM, MW, W_MKV, 64 * kb, n0, MW + n0, scr, lane); return; } r -= CV_I_MQ;
    if (r < CV_I_MO) { const int nb = DM / 64, kb = r / nb, n0 = 64 * (r % nb); p0_transpose_item(A_IN(19), MW, DM, W_MO, 64 * kb, n0, n0, scr, lane); return; } r -= CV_I_MO;
    if (r < CV_I_G) { const int nb = FF / 64, kb = r / nb, n0 = 64 * (r % nb); p0_transpose_item(A_IN(23), DM, FF, W_GU, 64 * kb, n0, 256 * (n0 / 128) + (n0 % 128), scr, lane, A_IN(22)); return; } r -= CV_I_G;
    if (r < CV_I_G) { const int nb = FF / 64, kb = r / nb, n0 = 64 * (r % nb); p0_transpose_item(A_IN(24), DM, FF, W_GU, 64 * kb, n0, 256 * (n0 / 128) + 128 + (n0 % 128), scr, lane, A_IN(22)); return; } r -= CV_I_G;
    { const int nb = DM / 64, kb = r / nb, n0 = 64 * (r % nb); p0_transpose_item(A_IN(25), FF, DM, W_DN, 64 * kb, n0, n0, scr, lane); }
}
#ifndef STAGGER_STEP
#define STAGGER_STEP 6
#endif
__device__ __forceinline__ void phase_stagger(int vcu) { for (int i = 0; i < (vcu & 31); ++i) __builtin_amdgcn_s_sleep(STAGGER_STEP); }
__device__ __forceinline__ void rs_panel(const float* PS, float* RS, int pm, int tid) {
    const int row = pm * 256 + (tid >> 1), half = tid & 1;
    const f32x4* p = (const f32x4*)(PS + (size_t)row * 64 + half * 32);
    float s = 0.f;
#pragma unroll
    for (int j = 0; j < 8; ++j) { const f32x4 v = p[j]; s += (v.x + v.y) + (v.z + v.w); }
    s += __shfl_xor(s, 1);
    if (!half) RS[row] = 1.0f / sqrtf(s * (1.f / DM) + NORM_EPS);
}
__global__ void __launch_bounds__(NWAVES * 64, 2) mk_fwd(Args args_unused) {
    extern __shared__ __attribute__((aligned(16))) unsigned char lds[];
    LAS unsigned char* const ldsL = (LAS unsigned char*)lds;
    volatile LAS unsigned* const MISC = (volatile LAS unsigned*)(ldsL + MISC_OFF);
    const int tid = threadIdx.x, lane = tid & 63, wave = __builtin_amdgcn_readfirstlane(tid >> 6);
    const int G = gridDim.x, bx = blockIdx.x, vcu = (G % 8 == 0) ? (bx % 8) * (G / 8) + bx / 8 : bx;
    unsigned char* const ws = KARGS->ws;
    gu32* const ctl = (gu32*)(ws + WS_CTL);
#define XIN (A_IN(0))
#define OUTR (KARGS->out)
#define OUTW (KARGS->outw)
    for (int u = tid; u < (LDS_BYTES - LDSCTL_OFF) / 4; u += NWAVES * 64) ((LAS unsigned*)(ldsL + LDSCTL_OFF))[u] = 0u;
    __syncthreads();
    XcdBarrier bar; bar.bar = (unsigned*)(ctl + CW_BAR) + KARGS->li * XCD_BAR_WORDS; bar.x = 0; bar.st = nullptr;
    if (N_LAUNCHES == 1) bar = xcd_barrier_post((unsigned*)(ctl + CW_BAR) + KARGS->li * XCD_BAR_WORDS, MISC + 8);
#define GRID_BAR(seam) do { if (N_LAUNCHES != 1) { if (tid == 0) __hip_atomic_store(ctl + CW_TMO, 0xBADBA0u | (unsigned)(seam), RLX_AGENT); } else { xcd_barrier(bar); } } while (0)
    const int lo = KARGS->ph_lo, hi = KARGS->ph_hi;
#ifndef PH_MASK
#define PH_MASK 0x3fff
#endif
#define IN(k) ((((PH_MASK) >> (k)) & 1) && lo <= (k) && (k) < hi)
#define BOTH(k) (IN(k) && IN((k) + 1))
    const int gw = vcu * NWAVES + wave, NGW = G * NWAVES;

    if (IN(0)) {
        LAS float* scr = (LAS float*)(ldsL + RING_OFF + wave * 16384);
        for (int it = gw; it < CV_P0_A; it += NGW) convert_item(it, ws, scr, lane);
        for (int it = CV_S_DN + gw; it < CV_S_DN + CV_DN_P0; it += NGW) convert_item(it, ws, scr, lane);
        for (int m = gw; m < M; m += NGW) rms_row_to_bf16(XIN + (size_t)m * DM, A_IN(2), XN + (size_t)m * DM, lane);
        for (int m = gw; m < MM; m += NGW) rms_row_to_bf16(A_IN(1) + (size_t)m * DM, A_IN(15), MEMN + (size_t)m * DM, lane);
        if (BOTH(0)) GRID_BAR(0);
    }
    if (IN(1)) {
        pg8::Gemm g{XN, W_IN, M, NIN, DM}; pg8::StaticOrder S; S.init(M, NIN, G, bx);
        { LAS float* gt = (LAS float*)(ldsL + EPIX_OFF + 10240); const int k = tid >> 7; const float* gsrc = k == 0 ? A_IN(4) : k == 1 ? A_IN(5) : k == 2 ? A_IN(6) : A_IN(7); gt[tid] = gsrc[tid & 127]; __syncthreads(); }
#ifdef PROBE_KMAX
        pg8::EpiHeads<pg8::PolProj> E{PROJ, KMEAN, (const float*)(size_t)(KARGS->li ? PROBE_KMAX : 3), ldsL + EPIX_OFF};
#else
        pg8::EpiHeads<pg8::PolProj> E{PROJ, KMEAN, nullptr, ldsL + EPIX_OFF};
#endif
        pg8::gemm_phase<pg8::EpiHeads<pg8::PolProj>, pg8::StaticOrder, true, PG8_SP2>(ldsL + RING_OFF, g, S, E);
        if (BOTH(1)) GRID_BAR(1);
    }
    if (IN(3)) {
        const float mnl_d_ = att_mnl(A_IN(6), A_IN(7), lane), mnl_m_ = att_mnl(A_IN(4), A_IN(5), lane);
#define get(idx) attn_get((idx), G, vcu, PROJ, MIX, DO, mnl_d_, mnl_m_)
        if (G == 256) {
            {
                float* kmL = (float*)((char*)lds + RING_OFF + att::LDS_KM_OFF);
#pragma unroll
                for (int mi = 0; mi < 2; ++mi) { const int hm = (mi * G + vcu) >> 2; const float* km = KMEAN + (size_t)hm * 8 * 128;
                    kmL[mi * 1024 + tid] = km[tid]; kmL[mi * 1024 + 512 + tid] = km[512 + tid]; }
            }
            att::BlockRef cur = get(0); att::Seam S; att::attn_prime<128, 128, DM, true>(cur, (char*)lds + RING_OFF, S);
            for (int i = 0; i < 12; ++i) { const att::BlockRef nxt = (i + 1 < 12) ? get(i + 1) : cur; att::attn_block<128, 128, DM, true>(cur, nxt, (char*)lds + RING_OFF, S); cur = nxt; }
            VM_WAIT(); __syncthreads();
            float lam;
            { const float a = A_IN(8)[lane] * A_IN(9)[lane] + A_IN(8)[lane + 64] * A_IN(9)[lane + 64];
              const float b = A_IN(10)[lane] * A_IN(11)[lane] + A_IN(10)[lane + 64] * A_IN(11)[lane + 64];
              lam = expf(wave_sum(a)) - expf(wave_sum(b)) + LAM_INIT; }
            const int half = lane >> 5, l5 = lane & 31, gb = vcu >> 5, gdh = (vcu >> 2) & 7, gx = vcu & 3;
            float gv[8];
            { const f32x4 g0 = *(const f32x4*)(A_IN(12) + 8 * l5), g1 = *(const f32x4*)(A_IN(12) + 8 * l5 + 4); gv[0] = g0.x; gv[1] = g0.y; gv[2] = g0.z; gv[3] = g0.w; gv[4] = g1.x; gv[5] = g1.y; gv[6] = g1.z; gv[7] = g1.w; }
            for (int it0 = 0; it0 < 32; it0 += 8) {
                v4u av[8], bv[8];
#pragma unroll
                for (int k = 0; k < 8; ++k) { const int rr = ((it0 + k) * NWAVES + wave) * 2 + half, qb = (rr < 256) ? gx : 7 - gx; const size_t row = (size_t)gb * SEQ + (size_t)qb * 256 + (rr & 255);
                    const bf16* p1 = DO + row * DM + gdh * 512 + 8 * l5; av[k] = *(const v4u*)p1; bv[k] = *(const v4u*)(p1 + 256); }
#pragma unroll
                for (int k = 0; k < 8; ++k) { const int rr = ((it0 + k) * NWAVES + wave) * 2 + half, qb = (rr < 256) ? gx : 7 - gx; const size_t row = (size_t)gb * SEQ + (size_t)qb * 256 + (rr & 255);
                    const unsigned aw[4] = {av[k].x, av[k].y, av[k].z, av[k].w}, bw[4] = {bv[k].x, bv[k].y, bv[k].z, bv[k].w};
                    float o[8]; float ss = 0.f;
#pragma unroll
                    for (int e = 0; e < 4; ++e) { o[2 * e] = __uint_as_float(aw[e] << 16) - lam * __uint_as_float(bw[e] << 16); o[2 * e + 1] = __uint_as_float(aw[e] & 0xffff0000u) - lam * __uint_as_float(bw[e] & 0xffff0000u); }
#pragma unroll
                    for (int e = 0; e < 8; ++e) ss += o[e] * o[e];
                    ss += __shfl_xor(ss, 1); ss += __shfl_xor(ss, 2); ss += __shfl_xor(ss, 4); ss += __shfl_xor(ss, 8); ss += __shfl_xor(ss, 16);
                    const float rs = (1.0f - LAM_INIT) / sqrtf(ss * (1.f / 256.f) + NORM_EPS);
                    v4u w; w.x = pk2(o[0] * rs * gv[0], o[1] * rs * gv[1]); w.y = pk2(o[2] * rs * gv[2], o[3] * rs * gv[3]); w.z = pk2(o[4] * rs * gv[4], o[5] * rs * gv[5]); w.w = pk2(o[6] * rs * gv[6], o[7] * rs * gv[7]);
                    *(v4u*)(MIX + row * DM + 2048 + gdh * 256 + 8 * l5) = w; }
            }
        }
#undef get
        if (BOTH(3)) GRID_BAR(3);
    }
    if (IN(5)) {
        pg8::Gemm g{MIX, W_OUT, M, DM, DM}; pg8::StaticOrder S; S.init(M, DM, G, bx);
        pg8::EpiResNorm<false> E{XIN, XN, PS_CROSS, DM, 64};
        pg8::gemm_phase<pg8::EpiResNorm<false>, pg8::StaticOrder, PG8_ALIGN, PG8_SP2>(ldsL + RING_OFF, g, S, E);
        if (BOTH(5)) GRID_BAR(5);
    }
    if (IN(7)) {
        { pg8::StaticOrder S0; S0.init(M, MW, G, bx); pg8::Unit u0; if (S0.next(0, u0)) rs_panel(PS_CROSS, RS_CROSS, u0.pm, tid); VM_WAIT(); __syncthreads(); }
        { pg8::Gemm g{XN, W_MQ, M, MW, DM}; pg8::StaticOrder S; S.init(M, MW, G, bx);
          { LAS float* gt = (LAS float*)(ldsL + EPIX_OFF + 10240); if (tid < 128) gt[tid] = A_IN(20)[tid]; __syncthreads(); }
          pg8::EpiHeads<pg8::PolQc> E{QC, nullptr, RS_CROSS, ldsL + EPIX_OFF};
          pg8::gemm_phase<pg8::EpiHeads<pg8::PolQc>, pg8::StaticOrder, true, PG8_SP2>(ldsL + RING_OFF, g, S, E); }
        { pg8::Gemm g{MEMN, W_MKV, MM, NKV, DM}; pg8::StaticOrder S; S.init(MM, NKV, G, (bx + G - 128) % G);
          { __syncthreads(); LAS float* gt = (LAS float*)(ldsL + EPIX_OFF + 10240); if (tid < 128) gt[tid] = A_IN(21)[tid]; __syncthreads(); }
          pg8::EpiHeads<pg8::PolKv> E{KVC, nullptr, nullptr, ldsL + EPIX_OFF};
          int t2 = threadIdx.x; asm volatile("" : "+v"(t2));
          pg8::gemm_phase<pg8::EpiHeads<pg8::PolKv>, pg8::StaticOrder, true, PG8_SP2>(ldsL + RING_OFF, g, S, E, t2); }
        if (G == 256 && bx >= 160) {
            LAS float* scr = (LAS float*)(ldsL + RING_OFF + wave * 16384);
            for (int it = CV_P0_A + (bx - 160) * NWAVES + wave; it < CV_S_DN; it += 96 * NWAVES) convert_item(it, ws, scr, lane);
        } else if (G != 256 && bx == 0) { LAS float* scr = (LAS float*)(ldsL + RING_OFF + wave * 16384); for (int it = CV_P0_A + wave; it < CV_S_DN; it += NWAVES) convert_item(it, ws, scr, lane); }
        if (BOTH(7)) GRID_BAR(7);
    }
    if (IN(9)) {
        const float mnl_c_ = att_mnl(A_IN(20), A_IN(21), lane);
        for (int I = vcu; I < BATCH * 4 * 8; I += G) {
            const int b = I >> 5, h = (I >> 3) & 3, qb = I & 7;
            att::BlockRef r; const size_t rq = (size_t)b * SEQ + (size_t)qb * 256, rk = (size_t)b * MEML;
            r.Q = QC + ((size_t)(h * BATCH + b) * SEQ + qb * 256) * 128; r.K = KVC + ((size_t)(h * BATCH + b) * MEML) * 128; r.V = KVC + ((size_t)((4 + h) * BATCH + b) * MEML) * 128; r.O = OC + rq * MW + h * 128; r.moba_qb = -1; r.kmi = 0; r.mnl = mnl_c_;
            r.P0 = 1 << 20; r.skv = MEML;
            att::Seam S; att::attn_prime<128, 128, MW, false>(r, (char*)lds + RING_OFF, S); att::attn_block<128, 128, MW, false>(r, r, (char*)lds + RING_OFF, S);
        }
        if (BOTH(9)) GRID_BAR(9);
    }
    if (IN(10)) {
        pg8::Gemm g{OC, W_MO, M, DM, MW}; pg8::StaticOrder S; S.init(M, DM, G, bx);
        pg8::EpiResNorm<true> E{nullptr, XN, PS_FFN, DM, 64};
        pg8::gemm_phase<pg8::EpiResNorm<true>, pg8::StaticOrder, PG8_ALIGN, PG8_SP2>(ldsL + RING_OFF, g, S, E);
        if (BOTH(10)) GRID_BAR(10);
    }
    if (IN(12)) {
        pg8::Gemm g{XN, W_GU, M, NGU, DM}; pg8::StaticOrder S; S.init(M, NGU, G, bx);
        { pg8::Unit u0; int last = -1; for (int i = 0; S.next(i, u0); ++i) if (u0.pm != last) { rs_panel(PS_FFN, RS_FFN, u0.pm, tid); last = u0.pm; } VM_WAIT(); __syncthreads(); }
        pg8::EpiSwiGLU E{HB, FF, RS_FFN};
        pg8::gemm_phase<pg8::EpiSwiGLU, pg8::StaticOrder, PG8_ALIGN, PG8_SP2, PG8_KSPLIT>(ldsL + RING_OFF, g, S, E);
        if (G == 256 && bx >= 128) {
            LAS float* scr = (LAS float*)(ldsL + RING_OFF + wave * 16384);
            for (int it = CV_S_DN + CV_DN_P0 + (bx - 128) * NWAVES + wave; it < CV_NITEMS; it += 128 * NWAVES) convert_item(it, ws, scr, lane);
        } else if (G != 256 && bx == 0) { LAS float* scr = (LAS float*)(ldsL + RING_OFF + wave * 16384); for (int it = CV_S_DN + CV_DN_P0 + wave; it < CV_NITEMS; it += NWAVES) convert_item(it, ws, scr, lane); }
        if (BOTH(12)) GRID_BAR(12);
    }
    if (IN(13)) {
        pg8::Gemm g{HB, W_DN, M, DM, FF}; pg8::StaticOrder S; S.init(M, DM, G, bx);
        pg8::EpiResOut E{XN, OUTW, DM};
        pg8::gemm_phase<pg8::EpiResOut, pg8::StaticOrder, PG8_ALIGN, PG8_SP2>(ldsL + RING_OFF, g, S, E);
    }
#undef IN
#undef BOTH
#undef XIN
#undef OUTR
#undef OUTW
}

extern "C" void kernel_launch(void* const* d_in, const int* in_sizes, int n_in, void* d_out, int out_size, void* d_ws, size_t ws_size, hipStream_t stream) {
    static int grid = 0;
    if (grid == 0) {
        if (n_in != 26 || in_sizes[0] != M * DM || out_size != M * DM || ws_size < WS_END) { fprintf(stderr, "kernel_launch: shape/workspace mismatch (n_in %d, in0 %d, out %d, ws %zu, need %zu)\n", n_in, n_in > 0 ? in_sizes[0] : -1, out_size, ws_size, (size_t)WS_END); grid = -1; return; }
        int dev = 0, cus = 0, per_cu = 0;
        if (hipGetDevice(&dev) != hipSuccess || hipDeviceGetAttribute(&cus, hipDeviceAttributeMultiprocessorCount, dev) != hipSuccess) { grid = -1; return; }
        if (hipFuncSetAttribute((const void*)mk_fwd, hipFuncAttributeMaxDynamicSharedMemorySize, LDS_BYTES) != hipSuccess) { fprintf(stderr, "kernel_launch: hipFuncSetAttribute failed\n"); grid = -1; return; }
        if (hipOccupancyMaxActiveBlocksPerMultiprocessor(&per_cu, (const void*)mk_fwd, NWAVES * 64, LDS_BYTES) != hipSuccess || per_cu < 1)
            fprintf(stderr, "kernel_launch: note: occupancy query reports %d workgroups per CU\n", per_cu);
        (void)hipGetLastError();
        grid = cus;
    }
    if (grid < 0) return;
    if (hipMemsetAsync((char*)d_ws + WS_CTL, 0, CTL_ZERO_BYTES, stream) != hipSuccess) return;
    Args a{};
    for (int i = 0; i < 26; ++i) a.in[i] = (const float*)d_in[i];
    a.out = (float*)d_out; a.outw = (float*)d_out; a.ws = (unsigned char*)d_ws;
    for (int li = 0; li < N_LAUNCHES; ++li) {
        a.ph_lo = (N_LAUNCHES == NPH) ? li : 0; a.ph_hi = (N_LAUNCHES == NPH) ? li + 1 : NPH; a.li = li; a.pad = 0;
        hipLaunchKernelGGL(mk_fwd, dim3(grid), dim3(NWAVES * 64), LDS_BYTES, stream, a);
        const hipError_t le = hipPeekAtLastError();
        if (le != hipSuccess) { fprintf(stderr, "kernel_launch: launch %d failed: %s\n", li, hipGetErrorName(le)); break; }
    }
#if defined(PROBE_LO)
    a.ph_lo = PROBE_LO; a.ph_hi = PROBE_HI; a.li = 1; a.outw = (float*)((char*)d_ws + WS_W_IN);
    hipLaunchKernelGGL(mk_fwd, dim3(grid), dim3(NWAVES * 64), LDS_BYTES, stream, a);
#endif
}
```

```cpp
#include <hip/hip_runtime.h>
#include <cstdio>
#include <cstdint>
namespace pg8 {
#define PG8_LAS __attribute__((address_space(3)))
typedef unsigned short bf16_t;
typedef short bf16x8 __attribute__((ext_vector_type(8)));
typedef float f32x4 __attribute__((ext_vector_type(4)));
typedef unsigned u32x4 __attribute__((ext_vector_type(4)));
constexpr int BM = 256, BK = 64, HALF = 128, HTB = HALF * BK * 2  , STAGE_BYTES = 8 * HTB, NXCD = 8, WGM = 8;

__host__ __device__ __forceinline__ int lds_byte(int r, int c) { const int st = (r >> 4) * 2 + (c >> 5), rr = r & 15, cc = c & 31, ob = rr * 64 + cc * 2; return st * 1024 + (ob ^ (((ob >> 9) & 1) << 5)); }
__host__ __device__ __forceinline__ void stage_rc(int b, int& R, int& C) { const int st = b / 1024, sb = b % 1024, swz = sb ^ (((sb >> 9) & 1) << 5); R = (st >> 1) * 16 + swz / 64; C = (st & 1) * 32 + (swz % 64) / 2; }
__host__ __device__ __forceinline__ int perm32(int rho) { const int n = rho >> 4, i = rho & 15; return 8 * (i >> 2) + 4 * n + (i & 3); }

struct Unit { int pm, pn; };
struct Gemm { const bf16_t* A; const bf16_t* Bt; int M, N, K; };

struct StaticOrder {
    int nM, nN, nwg, G, c, rot, wgm;
    __host__ __device__ void init(int M, int N, int G_, int c_, int rot_ = 0, int wgm_ = WGM) { nM = M / BM; nN = N / BM; nwg = nM * nN; G = G_; c = c_; rot = rot_; wgm = wgm_; }
    __host__ __device__ __forceinline__ bool next(int i, Unit& u) const {
        const long L = (long)i * G + c; if (L >= nwg) return false;
        int wgid = (int)L; { const int q = nwg / NXCD, r = nwg % NXCD, xcd = wgid % NXCD, off = wgid / NXCD; wgid = (xcd < r ? xcd * (q + 1) : r * (q + 1) + (xcd - r) * q) + off; }
        const int nig = wgm * nN, gid = wgid / nig, fm = gid * wgm, gsz = (nM - fm) < wgm ? (nM - fm) : wgm;
        u.pm = fm + ((wgid % nig) % gsz); u.pn = ((wgid % nig) / gsz + rot * gid) % nN; return true;
    }
    __device__ __forceinline__ void a_ready(const Unit&) const {}
    __device__ __forceinline__ void done(const Unit&) const {}
};

__device__ __forceinline__ unsigned cvt_pk_bf16(float lo, float hi) { unsigned r; asm volatile("v_cvt_pk_bf16_f32 %0, %1, %2" : "=v"(r) : "v"(lo), "v"(hi)); return r; }
typedef float f32x2 __attribute__((ext_vector_type(2)));
__device__ __forceinline__ f32x2 gelu_pk(f32x2 v) {
    const f32x2 av = __builtin_elementwise_abs(v), d = av * 0.2316418882f + 1.0f;
    f32x2 t; t.x = __builtin_amdgcn_rcpf(d.x); t.y = __builtin_amdgcn_rcpf(d.y);
    f32x2 q = t * 0.5307027145f + (-0.7265760135f); q = q * t + 0.7107068705f; q = q * t + (-0.142248368f); q = q * t + 0.127414796f; q = q * t;
    const f32x2 s = (v * v) * (-0.72134752044f);
    f32x2 e; e.x = __builtin_amdgcn_exp2f(s.x); e.y = __builtin_amdgcn_exp2f(s.y);
    const f32x2 m = v * (q * e), r = v - m;
    f32x2 o; o.x = v.x < 0.f ? m.x : r.x; o.y = v.y < 0.f ? m.y : r.y; return o;
}

template <int ACT  > struct EpiBf16 {
    static constexpr bool PERM = true, AFTER_DRAIN = false, PRELOAD = false; static_assert(ACT == 0 || ACT == 1, "EpiBf16: ACT is 0 (none) or 1 (gelu_pk)");
    bf16_t* O; int ldc; const float* bias; int split_cols; size_t split_stride; float scale0;
    __device__ __forceinline__ void operator()(const f32x4 (&acc)[2][2][4][2], const Unit& u, int wr, int wc, int fr, int fq) const {
        const int row0 = u.pm * BM + wr * 64 + fr; int colt = u.pn * BM; bf16_t* base = O;
        float sc = 1.f; if (split_cols) { const int t = colt / split_cols; base += (size_t)t * split_stride; colt -= t * split_cols; if (t == 0) sc = scale0; }
        const int col0 = colt + wc * 32 + 8 * fq, bcol0 = u.pn * BM + wc * 32 + 8 * fq;
        f32x4 bv[2][2];
#pragma unroll
        for (int bj = 0; bj < 2; ++bj)
#pragma unroll
            for (int n = 0; n < 2; ++n) bv[bj][n] = bias ? *(const f32x4*)(bias + bcol0 + bj * HALF + 4 * n) : (f32x4){0.f, 0.f, 0.f, 0.f};
#pragma unroll
        for (int ai = 0; ai < 2; ++ai)
#pragma unroll
            for (int m = 0; m < 4; ++m) { bf16_t* rowp = base + (size_t)(row0 + ai * HALF + m * 16) * ldc + col0;
#pragma unroll
                for (int bj = 0; bj < 2; ++bj) { f32x4 v0 = acc[ai][bj][m][0] + bv[bj][0], v1 = acc[ai][bj][m][1] + bv[bj][1];
                    if (ACT == 1) { f32x2 a = gelu_pk((f32x2){v0[0], v0[1]}), b = gelu_pk((f32x2){v0[2], v0[3]}), c = gelu_pk((f32x2){v1[0], v1[1]}), d = gelu_pk((f32x2){v1[2], v1[3]});
                        v0 = (f32x4){a.x, a.y, b.x, b.y}; v1 = (f32x4){c.x, c.y, d.x, d.y}; }
                    v0 = v0 * sc; v1 = v1 * sc; u32x4 w; w.x = cvt_pk_bf16(v0[0], v0[1]); w.y = cvt_pk_bf16(v0[2], v0[3]); w.z = cvt_pk_bf16(v1[0], v1[1]); w.w = cvt_pk_bf16(v1[2], v1[3]);
                    *(u32x4*)(rowp + bj * HALF) = w; } }
    }
};


struct EpiResF32 {
    static constexpr bool PERM = false, AFTER_DRAIN = false, PRELOAD = false;
    const float* base; float* out; int ldc;
    __device__ __forceinline__ void operator()(const f32x4 (&acc)[2][2][4][2], const Unit& u, int wr, int wc, int fr, int fq) const {
        const int row0 = u.pm * BM + wr * 64 + fr, col0 = u.pn * BM + wc * 32 + 4 * fq;
#pragma unroll
        for (int ai = 0; ai < 2; ++ai)
#pragma unroll
            for (int m = 0; m < 4; ++m) { const size_t off = (size_t)(row0 + ai * HALF + m * 16) * ldc + col0;
                f32x4 b[2][2];
#pragma unroll
                for (int bj = 0; bj < 2; ++bj)
#pragma unroll
                    for (int n = 0; n < 2; ++n) b[bj][n] = *(const f32x4*)(base + off + bj * HALF + n * 16);
#pragma unroll
                for (int bj = 0; bj < 2; ++bj)
#pragma unroll
                    for (int n = 0; n < 2; ++n) *(f32x4*)(out + off + bj * HALF + n * 16) = b[bj][n] + acc[ai][bj][m][n];
                if (m & 1) asm volatile("" ::: "memory"); }
    }
};
struct EpiSwiGLU {
    static constexpr bool PERM = true, AFTER_DRAIN = false, PRELOAD = true;
    __device__ __forceinline__ void preload(float (&pre)[8], const Unit& u, int wr, int fr) const {
#pragma unroll
        for (int i = 0; i < 8; ++i) { const float* p = RS + u.pm * BM + (i >> 2) * HALF + wr * 64 + (i & 3) * 16 + fr;
            asm volatile("global_load_dword %0, %1, off" : "=&v"(pre[i]) : "v"(p) : "memory"); } }
    bf16_t* H; int ldh; const float* RS;
    __device__ __forceinline__ void operator()(const f32x4 (&acc)[2][2][4][2], const Unit& u, int wr, int wc, int fr, int fq, const float (&pre)[8]) const {
        const int row0 = u.pm * BM + wr * 64 + fr, col0 = u.pn * HALF + wc * 32 + 8 * fq;
#pragma unroll
        for (int ai = 0; ai < 2; ++ai)
#pragma unroll
            for (int m = 0; m < 4; ++m) { const int row = row0 + ai * HALF + m * 16; bf16_t* rowp = H + (size_t)row * ldh + col0;
                const float rs = pre[ai * 4 + m], c1 = rs * -1.4426950408889634f, c2 = rs * rs;
                float h[8];
#pragma unroll
                for (int n = 0; n < 2; ++n)
#pragma unroll
                    for (int e = 0; e < 4; e += 2) { const f32x2 a0 = {acc[ai][0][m][n][e], acc[ai][0][m][n][e + 1]}, a1 = {acc[ai][1][m][n][e], acc[ai][1][m][n][e + 1]};
                        const f32x2 t = a0 * c1; f32x2 d; d.x = __builtin_amdgcn_exp2f(t.x); d.y = __builtin_amdgcn_exp2f(t.y); d = d + 1.0f;
                        f32x2 r; r.x = __builtin_amdgcn_rcpf(d.x); r.y = __builtin_amdgcn_rcpf(d.y);
                        const f32x2 o = ((a0 * a1) * c2) * r; h[n * 4 + e] = o.x; h[n * 4 + e + 1] = o.y; }
                u32x4 w; w.x = cvt_pk_bf16(h[0], h[1]); w.y = cvt_pk_bf16(h[2], h[3]); w.z = cvt_pk_bf16(h[4], h[5]); w.w = cvt_pk_bf16(h[6], h[7]);
                *(u32x4*)rowp = w; }
    }
};

template <bool BASE_BF16> struct EpiResNorm {
    static constexpr bool PERM = true, AFTER_DRAIN = false, PRELOAD = false;
    const float* base; bf16_t* XB; float* PS; int ldc, nps;
    __device__ __forceinline__ void operator()(const f32x4 (&acc)[2][2][4][2], const Unit& u, int wr, int wc, int fr, int fq) const {
        const int row0 = u.pm * BM + wr * 64 + fr, col0 = u.pn * BM + wc * 32 + 8 * fq;
#pragma unroll
        for (int ai = 0; ai < 2; ++ai)
#pragma unroll
            for (int m = 0; m < 4; ++m) { const int row = row0 + ai * HALF + m * 16; const size_t off = (size_t)row * ldc + col0;
                f32x4 b[2][2];
#pragma unroll
                for (int bj = 0; bj < 2; ++bj) {
                    if constexpr (BASE_BF16) { const u32x4 r = *(const u32x4*)(XB + off + bj * HALF);
                        b[bj][0] = (f32x4){__uint_as_float(r.x << 16), __uint_as_float(r.x & 0xffff0000u), __uint_as_float(r.y << 16), __uint_as_float(r.y & 0xffff0000u)};
                        b[bj][1] = (f32x4){__uint_as_float(r.z << 16), __uint_as_float(r.z & 0xffff0000u), __uint_as_float(r.w << 16), __uint_as_float(r.w & 0xffff0000u)}; }
                    else { b[bj][0] = *(const f32x4*)(base + off + bj * HALF); b[bj][1] = *(const f32x4*)(base + off + bj * HALF + 4); } }
                float ss = 0.f;
#pragma unroll
                for (int bj = 0; bj < 2; ++bj) { const f32x4 v0 = b[bj][0] + acc[ai][bj][m][0], v1 = b[bj][1] + acc[ai][bj][m][1];
                    ss += (v0[0] * v0[0] + v0[1] * v0[1]) + (v0[2] * v0[2] + v0[3] * v0[3]) + (v1[0] * v1[0] + v1[1] * v1[1]) + (v1[2] * v1[2] + v1[3] * v1[3]);
                    u32x4 w; w.x = cvt_pk_bf16(v0[0], v0[1]); w.y = cvt_pk_bf16(v0[2], v0[3]); w.z = cvt_pk_bf16(v1[0], v1[1]); w.w = cvt_pk_bf16(v1[2], v1[3]);
                    *(u32x4*)(XB + off + bj * HALF) = w; }
                ss += __shfl_xor(ss, 16); ss += __shfl_xor(ss, 32);
                if (fq == 0) PS[(size_t)row * nps + u.pn * 4 + wc] = ss;
                if (m & 1) asm volatile("" ::: "memory"); }
    }
};
struct EpiResOut {
    static constexpr bool PERM = true, AFTER_DRAIN = false, PRELOAD = false;
    const bf16_t* XB; float* out; int ldc;
    __device__ __forceinline__ void operator()(const f32x4 (&acc)[2][2][4][2], const Unit& u, int wr, int wc, int fr, int fq) const {
        const int row0 = u.pm * BM + wr * 64 + fr, col0 = u.pn * BM + wc * 32 + 8 * fq;
#pragma unroll
        for (int ai = 0; ai < 2; ++ai)
#pragma unroll
            for (int m = 0; m < 4; ++m) { const size_t off = (size_t)(row0 + ai * HALF + m * 16) * ldc + col0;
                u32x4 r[2];
#pragma unroll
                for (int bj = 0; bj < 2; ++bj) r[bj] = *(const u32x4*)(XB + off + bj * HALF);
#pragma unroll
                for (int bj = 0; bj < 2; ++bj) {
                    const f32x4 b0 = {__uint_as_float(r[bj].x << 16), __uint_as_float(r[bj].x & 0xffff0000u), __uint_as_float(r[bj].y << 16), __uint_as_float(r[bj].y & 0xffff0000u)};
                    const f32x4 b1 = {__uint_as_float(r[bj].z << 16), __uint_as_float(r[bj].z & 0xffff0000u), __uint_as_float(r[bj].w << 16), __uint_as_float(r[bj].w & 0xffff0000u)};
                    *(f32x4*)(out + off + bj * HALF) = b0 + acc[ai][bj][m][0]; *(f32x4*)(out + off + bj * HALF + 4) = b1 + acc[ai][bj][m][1]; }
                if (m & 1) asm volatile("" ::: "memory"); }
    }
};
struct EpiBf16RS {
    static constexpr bool PERM = true, AFTER_DRAIN = false, PRELOAD = false;
    bf16_t* O; int ldc; const float* RS;
    __device__ __forceinline__ void operator()(const f32x4 (&acc)[2][2][4][2], const Unit& u, int wr, int wc, int fr, int fq) const {
        const int row0 = u.pm * BM + wr * 64 + fr, col0 = u.pn * BM + wc * 32 + 8 * fq;
#pragma unroll
        for (int ai = 0; ai < 2; ++ai)
#pragma unroll
            for (int m = 0; m < 4; ++m) { const int row = row0 + ai * HALF + m * 16; bf16_t* rowp = O + (size_t)row * ldc + col0;
                const float rs = RS[row];
#pragma unroll
                for (int bj = 0; bj < 2; ++bj) { const f32x4 v0 = acc[ai][bj][m][0] * rs, v1 = acc[ai][bj][m][1] * rs;
                    u32x4 w; w.x = cvt_pk_bf16(v0[0], v0[1]); w.y = cvt_pk_bf16(v0[2], v0[3]); w.z = cvt_pk_bf16(v1[0], v1[1]); w.w = cvt_pk_bf16(v1[2], v1[3]);
                    *(u32x4*)(rowp + bj * HALF) = w; } }
    }
};

__host__ __device__ __forceinline__ int rope_slot(int d) { if (d < 32) return 32 * ((d & 15) >> 2) + 4 * (d >> 4) + (d & 3); const int g = (d - 32) >> 3; return 32 * (g / 3) + 8 * (1 + g % 3) + (d & 7); }
template <class Pol> struct EpiHeads {
    static constexpr bool PERM = true, AFTER_DRAIN = false, PRELOAD = false;
    bf16_t* T; float* kmean; const float* RS; PG8_LAS unsigned char* xl;
    __device__ __forceinline__ void operator()(const f32x4 (&acc)[2][2][4][2], const Unit& u, int wr, int wc, int fr, int fq) const {
#ifdef PROBE_KMAX
        const int kind = (Pol::TPB == 8 && !Pol::HAS_RS) ? min(Pol::kind(u.pn), (int)(size_t)RS) : Pol::kind(u.pn);
#else
        const int kind = Pol::kind(u.pn);
#endif
        const int b = u.pm / Pol::TPB, s0 = (u.pm % Pol::TPB) * BM;
        PG8_LAS float* P = (PG8_LAS float*)xl;
        PG8_LAS float* KS = (PG8_LAS float*)(xl + 8192);
#define EH_RSC(ai, m) (Pol::HAS_RS ? RS[u.pm * BM + (ai) * HALF + wr * 64 + (m) * 16 + fr] : 1.f)
        if (kind >= 1) {
#pragma unroll
            for (int ai = 0; ai < 2; ++ai)
#pragma unroll
                for (int m = 0; m < 4; ++m)
#pragma unroll
                    for (int bj = 0; bj < 2; ++bj) { const float rsc_ = EH_RSC(ai, m); const f32x4 a0 = acc[ai][bj][m][0] * rsc_, a1 = acc[ai][bj][m][1] * rsc_;
                        float ss = (a0[0] * a0[0] + a0[1] * a0[1]) + (a0[2] * a0[2] + a0[3] * a0[3]) + (a1[0] * a1[0] + a1[1] * a1[1]) + (a1[2] * a1[2] + a1[3] * a1[3]);
                        ss += __shfl_xor(ss, 16); ss += __shfl_xor(ss, 32);
                        if (fq == 0) P[(bj * BM + ai * HALF + wr * 64 + m * 16 + fr) * 4 + wc] = ss; }
            asm volatile("s_waitcnt lgkmcnt(0)" ::: "memory"); __builtin_amdgcn_s_barrier(); asm volatile("" ::: "memory");
        }
        const PG8_LAS float* g = (const PG8_LAS float*)(xl + 10240) + Pol::gain(u.pn) * 128;
        f32x4 gv0 = {1.f, 1.f, 1.f, 1.f}, gv1 = {1.f, 1.f, 1.f, 1.f};
        const int d0 = kind >= 2 ? (fq == 0 ? 4 * wc : 32 + 8 * (3 * wc + fq - 1)) : wc * 32 + 8 * fq, d1 = (kind >= 2 && fq == 0) ? 16 + 4 * wc : d0 + 4;
        if (kind >= 1) { const float qs = Pol::qscale(u.pn); gv0 = *(const PG8_LAS f32x4*)(g + d0) * qs; gv1 = *(const PG8_LAS f32x4*)(g + d1) * qs; }
        f32x4 cs[2][2];
#pragma unroll
        for (int bj = 0; bj < 2; ++bj) { cs[bj][0] = (f32x4){0.f, 0.f, 0.f, 0.f}; cs[bj][1] = (f32x4){0.f, 0.f, 0.f, 0.f}; }
#pragma unroll
        for (int ai = 0; ai < 2; ++ai)
#pragma unroll
            for (int m = 0; m < 4; ++m) { const int r = ai * HALF + wr * 64 + m * 16 + fr;
                f32x4 y[2][2];
#pragma unroll
                for (int bj = 0; bj < 2; ++bj) { float rs = EH_RSC(ai, m);
                    if (kind >= 1) { const f32x4 p = *(const PG8_LAS f32x4*)(P + (bj * BM + r) * 4); rs *= __builtin_amdgcn_rsqf(((p[0] + p[1]) + (p[2] + p[3])) * (1.f / 128.f) + 1e-6f); }
                    y[bj][0] = acc[ai][bj][m][0] * rs * gv0; y[bj][1] = acc[ai][bj][m][1] * rs * gv1; }
                if (kind >= 2) {
                    constexpr float KTH[4] = {1.000000000e+00f, 4.403666027e-01f, 1.939227447e-01f, 8.539710029e-02f};
                    const float arev = (float)(s0 + r) * (wc == 0 ? 0.15915494309f : wc == 1 ? 5.985185713e-03f : wc == 2 ? 2.250790790e-04f : 8.464330808e-06f);
                    if (fq == 0) {
                        f32x4 c0, sn0;
#pragma unroll
                        for (int e = 0; e < 4; ++e) { const float t0 = __builtin_amdgcn_fractf(arev * KTH[e]); c0[e] = __builtin_amdgcn_cosf(t0); sn0[e] = __builtin_amdgcn_sinf(t0); }
#pragma unroll
                        for (int bj = 0; bj < 2; ++bj) { const f32x4 x1 = y[bj][0], x2 = y[bj][1];
                            y[bj][0] = x1 * c0 - x2 * sn0; y[bj][1] = x2 * c0 + x1 * sn0; } }
                }
#pragma unroll
                for (int bj = 0; bj < 2; ++bj) {
                    if (kind == 3) { cs[bj][0] += y[bj][0]; cs[bj][1] += y[bj][1]; }
                    u32x4 w; w.x = cvt_pk_bf16(y[bj][0][0], y[bj][0][1]); w.y = cvt_pk_bf16(y[bj][0][2], y[bj][0][3]); w.z = cvt_pk_bf16(y[bj][1][0], y[bj][1][1]); w.w = cvt_pk_bf16(y[bj][1][2], y[bj][1][3]);
#ifdef PROBE_KMAX
                    if (kind >= 0)
#endif
                    { bf16_t* tp = T + ((size_t)((2 * u.pn + bj) * Pol::NB + b) * Pol::S + s0 + r) * 128;
                      if (kind >= 2) { *(unsigned long long*)(tp + d0) = (unsigned long long)w.x | ((unsigned long long)w.y << 32); *(unsigned long long*)(tp + d1) = (unsigned long long)w.z | ((unsigned long long)w.w << 32); }
                      else *(u32x4*)(tp + d0) = w; } }
                asm volatile("" ::: "memory");
            }
        if (kind == 3) {
#pragma unroll
            for (int bj = 0; bj < 2; ++bj)
#pragma unroll
                for (int n = 0; n < 2; ++n)
#pragma unroll
                    for (int e = 0; e < 4; ++e) { float v = cs[bj][n][e]; v += __shfl_xor(v, 1); v += __shfl_xor(v, 2); v += __shfl_xor(v, 4); v += __shfl_xor(v, 8); cs[bj][n][e] = v; }
            if (fr == 0) {
#pragma unroll
                for (int bj = 0; bj < 2; ++bj) { *(PG8_LAS f32x4*)(KS + wr * 256 + bj * HALF + d0) = cs[bj][0]; *(PG8_LAS f32x4*)(KS + wr * 256 + bj * HALF + d1) = cs[bj][1]; } }
            asm volatile("s_waitcnt lgkmcnt(0)" ::: "memory"); __builtin_amdgcn_s_barrier(); asm volatile("" ::: "memory");
            int t = threadIdx.x; asm volatile("" : "+v"(t));
            if (t < 256) { const int h = Pol::kmhead(u.pn) + (t >> 7);
                kmean[((size_t)(b * 16 + h) * 8 + (u.pm % Pol::TPB)) * 128 + (t & 127)] = (KS[t] + KS[256 + t]) * (1.f / 256.f); }
        }
    }
};
#undef EH_RSC
struct PolProj {
    static constexpr int TPB = 8, NB = 8, S = 2048; static constexpr bool HAS_RS = false;
    __device__ static __forceinline__ int kind(int pn) { return pn < 8 ? 2 : pn < 16 ? 3 : pn < 24 ? 0 : pn < 40 ? 2 : 0; }
    __device__ static __forceinline__ int gain(int pn) { return pn < 8 ? 0 : pn < 16 ? 1 : pn < 32 ? 2 : 3; }
    __device__ static __forceinline__ int kmhead(int pn) { return 2 * (pn - 8); }
    __device__ static __forceinline__ float qscale(int pn) { return (pn < 8 || (pn >= 24 && pn < 32)) ? 0.12751743074602325f : 1.f; }
};
struct PolQc {
    static constexpr int TPB = 8, NB = 8, S = 2048; static constexpr bool HAS_RS = true;
    __device__ static __forceinline__ float qscale(int) { return 0.12751743074602325f; }
    __device__ static __forceinline__ int kind(int) { return 1; }
    __device__ static __forceinline__ int gain(int) { return 0; }
    __device__ static __forceinline__ int kmhead(int) { return 0; }
};
struct PolKv {
    static constexpr int TPB = 1, NB = 8, S = 256; static constexpr bool HAS_RS = false;
    __device__ static __forceinline__ float qscale(int) { return 1.f; }
    __device__ static __forceinline__ int kind(int pn) { return pn < 2 ? 1 : 0; }
    __device__ static __forceinline__ int gain(int) { return 0; }
    __device__ static __forceinline__ int kmhead(int) { return 0; }
};

template <class Epi, class Sched, bool ALIGN_EPI = false, bool SP2 = false, bool KSPLIT = false>
__device__ __forceinline__ void gemm_phase(PG8_LAS unsigned char* lds, const Gemm g, const Sched& S, const Epi& E, const int tid_in = -1) {
    const int tid = tid_in < 0 ? (int)threadIdx.x : tid_in, wid = __builtin_amdgcn_readfirstlane(tid >> 6), lane = tid & 63, wr = wid >> 2, wc = wid & 3, fr = lane & 15, fq = lane >> 4;
    const int K = g.K, nt = K / BK;
    unsigned voffA[2], voffB[2];
#pragma unroll
    for (int i = 0; i < 2; ++i) { int R, C; stage_rc(tid * 16 + i * 8192, R, C); const int Rb = Epi::PERM ? ((R & ~31) + perm32(R & 31)) : R;
        voffA[i] = (unsigned)(R * K + C) * 2u; voffB[i] = (unsigned)(Rb * K + C) * 2u; }
    unsigned vA2[2], vB2[2];
#pragma unroll
    for (int h = 0; h < 2; ++h) { int R, C; stage_rc((2 * wid + h) * 1024 + lane * 16, R, C); const int Rb = Epi::PERM ? ((R & ~31) + perm32(R & 31)) : R;
        vA2[h] = (unsigned)(R * K + C) * 2u; vB2[h] = (unsigned)(Rb * K + C) * 2u; }
    const size_t kstep = (size_t)(BK * 2);
    const size_t hstep = (size_t)HALF * K * 2;
    const size_t tstep = 2 * hstep;
    const unsigned ldsw = (unsigned)wid * 1024u;
    const int aoff = lds_byte(wr * 64 + fr, fq * 8), boff = lds_byte(wc * 32 + fr, fq * 8);
#define PG8_SA(b, h) (((b) * 2 + (h)) * HTB)
#define PG8_SB(b, h) ((4 + (b) * 2 + (h)) * HTB)
#define PG8_STAGE(bufoff, gbase, voff) do { _Pragma("unroll") for (int _i = 0; _i < 2; ++_i) \
        __builtin_amdgcn_global_load_lds((const unsigned*)((const char*)(gbase) + (voff)[_i]), (PG8_LAS unsigned*)(lds + (bufoff) + ldsw + _i * 8192), 16, 0, 0); } while (0)
#define PG8_LDA(dst, b, h) do { _Pragma("unroll") for (int m = 0; m < 4; ++m) _Pragma("unroll") for (int k = 0; k < 2; ++k) dst[m][k] = *(const PG8_LAS bf16x8*)(lds + PG8_SA(b, h) + aoff + m * 2048 + k * 1024); } while (0)
#define PG8_LDB(dst, b, h) do { _Pragma("unroll") for (int n = 0; n < 2; ++n) _Pragma("unroll") for (int k = 0; k < 2; ++k) dst[n][k] = *(const PG8_LAS bf16x8*)(lds + PG8_SB(b, h) + boff + n * 2048 + k * 1024); } while (0)
#define PG8_MMA(ai, bj, At, Bt) do { __builtin_amdgcn_s_setprio(1); _Pragma("unroll") for (int m = 0; m < 4; ++m) _Pragma("unroll") for (int n = 0; n < 2; ++n) _Pragma("unroll") for (int k = 0; k < 2; ++k) \
        acc[ai][bj][m][n] = __builtin_amdgcn_mfma_f32_16x16x32_bf16(Bt[n][k], At[m][k], acc[ai][bj][m][n], 0, 0, 0); __builtin_amdgcn_s_setprio(0); } while (0)
#define PG8_STG1(bufoff, gbase, voffh, h) __builtin_amdgcn_global_load_lds((const unsigned*)((const char*)(gbase) + (voffh)), (PG8_LAS unsigned*)(lds + (bufoff) + (2 * wid + (h)) * 1024), 16, 0, 0)
#define PG8_STAGE_K(b, h, ap, bp) do { PG8_STG1(PG8_SA(b, 0), ap, vA2[h], h); PG8_STG1(PG8_SA(b, 1), (ap) + hstep, vA2[h], h); PG8_STG1(PG8_SB(b, 0), bp, vB2[h], h); PG8_STG1(PG8_SB(b, 1), (bp) + hstep, vB2[h], h); } while (0)
#define PG8_LDK(b, k) do { _Pragma("unroll") for (int ai = 0; ai < 2; ++ai) _Pragma("unroll") for (int m = 0; m < 4; ++m) Af[ai][m] = *(const PG8_LAS bf16x8*)(lds + PG8_SA(b, ai) + aoff + m * 2048 + (k) * 1024); \
        _Pragma("unroll") for (int bj = 0; bj < 2; ++bj) _Pragma("unroll") for (int n = 0; n < 2; ++n) Bf[bj][n] = *(const PG8_LAS bf16x8*)(lds + PG8_SB(b, bj) + boff + n * 2048 + (k) * 1024); } while (0)
#define PG8_MMK() do { __builtin_amdgcn_s_setprio(1); _Pragma("unroll") for (int ai = 0; ai < 2; ++ai) _Pragma("unroll") for (int bj = 0; bj < 2; ++bj) _Pragma("unroll") for (int m = 0; m < 4; ++m) _Pragma("unroll") for (int n = 0; n < 2; ++n) \
        acc[ai][bj][m][n] = __builtin_amdgcn_mfma_f32_16x16x32_bf16(Bf[bj][n], Af[ai][m], acc[ai][bj][m][n], 0, 0, 0); __builtin_amdgcn_s_setprio(0); } while (0)
#define PG8_WAIT_V(n) asm volatile("s_waitcnt vmcnt(" #n ")" ::: "memory")
#define PG8_WAIT_L(n) asm volatile("s_waitcnt lgkmcnt(" #n ")" ::: "memory")
#define PG8_BAR __builtin_amdgcn_s_barrier()
#define PG8_SCHED __builtin_amdgcn_sched_barrier(0)
    Unit cur, nxt; int ui = 0;
    if (!S.next(0, cur)) return;
    f32x4 acc[2][2][4][2];
#pragma unroll
    for (int a = 0; a < 2; ++a)
#pragma unroll
        for (int b = 0; b < 2; ++b)
#pragma unroll
            for (int m = 0; m < 4; ++m)
#pragma unroll
                for (int n = 0; n < 2; ++n) acc[a][b][m][n] = (f32x4){0.f, 0.f, 0.f, 0.f};
    bf16x8 At[4][2], B0[2][2], B1[2][2];
    bf16x8 Af[2][4], Bf[2][2];
    const char* cA = (const char*)g.A + (size_t)cur.pm * tstep; const char* cB = (const char*)g.Bt + (size_t)cur.pn * tstep;
    S.a_ready(cur);
    float pre[8]; if constexpr (Epi::PRELOAD) E.preload(pre, cur, wr, fr);
    if constexpr (KSPLIT) {
        PG8_STAGE_K(0, 0, cA, cB); PG8_STAGE_K(0, 1, cA, cB); PG8_STAGE_K(1, 0, cA + kstep, cB + kstep);
        if (wr == 1) PG8_BAR;
        PG8_WAIT_V(8); PG8_BAR;
        PG8_BAR;
    } else
    if constexpr (SP2) {
        PG8_STAGE(PG8_SB(0, 0), cB, voffB); PG8_STAGE(PG8_SB(0, 1), cB + hstep, voffB); PG8_STAGE(PG8_SA(0, 0), cA, voffA); PG8_STAGE(PG8_SA(0, 1), cA + hstep, voffA);
        if (wr == 1) PG8_BAR;
        PG8_WAIT_V(2); PG8_BAR;
        PG8_STAGE(PG8_SB(1, 0), cB + kstep, voffB); PG8_STAGE(PG8_SA(1, 0), cA + kstep, voffA); PG8_STAGE(PG8_SB(1, 1), cB + hstep + kstep, voffB);
        PG8_WAIT_V(6); PG8_BAR;
    } else {
        PG8_STAGE(PG8_SB(0, 0), cB, voffB); PG8_STAGE(PG8_SA(0, 0), cA, voffA); PG8_STAGE(PG8_SB(0, 1), cB + hstep, voffB); PG8_STAGE(PG8_SA(0, 1), cA + hstep, voffA);
        if (wr == 1) PG8_BAR;
        PG8_WAIT_V(4); PG8_BAR;
        PG8_STAGE(PG8_SB(1, 0), cB + kstep, voffB); PG8_STAGE(PG8_SA(1, 0), cA + kstep, voffA); PG8_STAGE(PG8_SB(1, 1), cB + hstep + kstep, voffB);
        PG8_WAIT_V(6); PG8_BAR;
    }
    for (;;) {
        const bool has_next = S.next(ui + 1, nxt);
        const char* nA = has_next ? (const char*)g.A + (size_t)nxt.pm * tstep : cA; const char* nB = has_next ? (const char*)g.Bt + (size_t)nxt.pn * tstep : cB;
        for (int t = 0; t < nt; t += 2) {
            const bool last = (t == nt - 2);
            const char* a1 = cA + (size_t)(t + 1) * kstep;
            const char* a2 = last ? nA : cA + (size_t)(t + 2) * kstep; const char* b2 = last ? nB : cB + (size_t)(t + 2) * kstep;
            const char* a3 = a2 + kstep; const char* b3 = b2 + kstep;
            if (last && has_next) S.a_ready(nxt);
            if constexpr (KSPLIT) {
            const char* b1 = cB + (size_t)(t + 1) * kstep;
            PG8_LDK(0, 0); PG8_STAGE_K(1, 1, a1, b1); PG8_WAIT_V(8); PG8_WAIT_L(0); PG8_BAR; PG8_MMK(); PG8_BAR; PG8_SCHED;
            PG8_LDK(0, 1); PG8_STAGE_K(0, 0, a2, b2); PG8_WAIT_V(8); PG8_WAIT_L(0); PG8_BAR; PG8_MMK(); PG8_BAR; PG8_SCHED;
            PG8_LDK(1, 0); PG8_STAGE_K(0, 1, a2, b2); PG8_WAIT_V(8); PG8_WAIT_L(0); PG8_BAR; PG8_MMK(); PG8_BAR; PG8_SCHED;
            PG8_LDK(1, 1); PG8_STAGE_K(1, 0, a3, b3); PG8_WAIT_V(8); PG8_WAIT_L(0); PG8_BAR; PG8_MMK(); PG8_BAR; PG8_SCHED;
            } else
            if constexpr (SP2) {
            PG8_LDB(B0, 0, 0); PG8_LDB(B1, 0, 1); PG8_SCHED; PG8_LDA(At, 0, 0); PG8_STAGE(PG8_SA(1, 1), a1 + hstep, voffA);
            PG8_WAIT_V(8); PG8_WAIT_L(0); PG8_BAR; PG8_MMA(0, 0, At, B0); PG8_MMA(0, 1, At, B1); PG8_BAR; PG8_SCHED;
            PG8_LDA(At, 0, 1); PG8_STAGE(PG8_SB(0, 0), b2, voffB); PG8_STAGE(PG8_SB(0, 1), b2 + hstep, voffB); PG8_STAGE(PG8_SA(0, 0), a2, voffA);
            PG8_WAIT_V(8); PG8_WAIT_L(0); PG8_BAR; PG8_MMA(1, 0, At, B0); PG8_MMA(1, 1, At, B1); PG8_BAR; PG8_SCHED;
            PG8_LDB(B0, 1, 0); PG8_LDB(B1, 1, 1); PG8_SCHED; PG8_LDA(At, 1, 0); PG8_STAGE(PG8_SA(0, 1), a2 + hstep, voffA);
            PG8_WAIT_V(8); PG8_WAIT_L(0); PG8_BAR; PG8_MMA(0, 0, At, B0); PG8_MMA(0, 1, At, B1); PG8_BAR; PG8_SCHED;
            PG8_LDA(At, 1, 1); PG8_STAGE(PG8_SB(1, 0), b3, voffB); PG8_STAGE(PG8_SB(1, 1), b3 + hstep, voffB); PG8_STAGE(PG8_SA(1, 0), a3, voffA);
            PG8_WAIT_V(8); PG8_WAIT_L(0); PG8_BAR; PG8_MMA(1, 0, At, B0); PG8_MMA(1, 1, At, B1); PG8_BAR; PG8_SCHED;
            } else {
            PG8_LDB(B0, 0, 0); PG8_SCHED; PG8_LDA(At, 0, 0); PG8_STAGE(PG8_SA(1, 1), a1 + hstep, voffA);
            PG8_WAIT_L(8); PG8_BAR; PG8_WAIT_L(0); PG8_MMA(0, 0, At, B0); PG8_BAR; PG8_SCHED;
            PG8_LDB(B1, 0, 1); PG8_STAGE(PG8_SB(0, 0), b2, voffB);
            PG8_BAR; PG8_WAIT_L(0); PG8_MMA(0, 1, At, B1); PG8_BAR;
            PG8_LDA(At, 0, 1); PG8_STAGE(PG8_SA(0, 0), a2, voffA);
            PG8_BAR; PG8_WAIT_L(0); PG8_MMA(1, 0, At, B0); PG8_BAR; PG8_SCHED;
            PG8_STAGE(PG8_SB(0, 1), b2 + hstep, voffB);
            PG8_WAIT_V(6); PG8_BAR; PG8_MMA(1, 1, At, B1); PG8_BAR;
            PG8_LDB(B0, 1, 0); PG8_SCHED; PG8_LDA(At, 1, 0); PG8_STAGE(PG8_SA(0, 1), a2 + hstep, voffA);
            PG8_WAIT_L(8); PG8_BAR; PG8_WAIT_L(0); PG8_MMA(0, 0, At, B0); PG8_BAR; PG8_SCHED;
            PG8_LDB(B1, 1, 1); PG8_STAGE(PG8_SB(1, 0), b3, voffB);
            PG8_BAR; PG8_WAIT_L(0); PG8_MMA(0, 1, At, B1); PG8_BAR;
            PG8_LDA(At, 1, 1); PG8_STAGE(PG8_SA(1, 0), a3, voffA);
            PG8_BAR; PG8_WAIT_L(0); PG8_MMA(1, 0, At, B0); PG8_BAR; PG8_SCHED;
            PG8_STAGE(PG8_SB(1, 1), b3 + hstep, voffB);
            PG8_WAIT_V(6); PG8_BAR; PG8_MMA(1, 1, At, B1); PG8_BAR;
            }
        }
        if constexpr (ALIGN_EPI) { if (wr == 0) PG8_BAR; }
        if constexpr (!Epi::AFTER_DRAIN) { if constexpr (Epi::PRELOAD) E(acc, cur, wr, wc, fr, fq, pre); else E(acc, cur, wr, wc, fr, fq); S.done(cur); }
        if (!has_next) break;
#pragma unroll
        for (int a = 0; a < 2; ++a)
#pragma unroll
            for (int b = 0; b < 2; ++b)
#pragma unroll
                for (int m = 0; m < 4; ++m)
#pragma unroll
                    for (int n = 0; n < 2; ++n) acc[a][b][m][n] = (f32x4){0.f, 0.f, 0.f, 0.f};
        cur = nxt; cA = nA; cB = nB; ++ui;
        if constexpr (Epi::PRELOAD) E.preload(pre, cur, wr, fr);
        if constexpr (ALIGN_EPI) { if (wr == 1) PG8_BAR; }
    }
    PG8_WAIT_V(0);
    if constexpr (!ALIGN_EPI) { if (wr == 0) PG8_BAR; }
    PG8_BAR;
    if constexpr (Epi::AFTER_DRAIN) { E.fused(acc, cur, wr, wc, fr, fq, lds, wid, lane); S.done(cur); }
#undef PG8_SA
#undef PG8_SB
#undef PG8_STAGE
#undef PG8_LDA
#undef PG8_LDB
#undef PG8_MMA
#undef PG8_STG1
#undef PG8_STAGE_K
#undef PG8_LDK
#undef PG8_MMK
#undef PG8_WAIT_V
#undef PG8_WAIT_L
#undef PG8_BAR
#undef PG8_SCHED
}
}

#ifndef PG8_KSPLIT
#define PG8_KSPLIT false
#endif
#ifndef PG8_SP2
#define PG8_SP2 true
#endif
#ifndef PG8_ALIGN
#define PG8_ALIGN true
#endif


namespace att {
typedef unsigned short bf16;
typedef short bf16x8 __attribute__((ext_vector_type(8)));
typedef short s16x4 __attribute__((ext_vector_type(4)));
typedef float f32x16 __attribute__((ext_vector_type(16)));
typedef float f32x4 __attribute__((ext_vector_type(4)));
typedef unsigned u32x4 __attribute__((ext_vector_type(4)));
constexpr int NW = 8, QBLK = 32, KVBLK = 64, QB = NW * QBLK, D = 128;
constexpr float SCALE = 0.08838834764831845f;
constexpr float THR = 8.f;
constexpr int SHM_V = KVBLK * D * 2, SHM_K = KVBLK * D * 2;
constexpr int NVB = 3;
constexpr int LDS_WS_OFF = NVB * SHM_V + 2 * SHM_K, LDS_KM_OFF = LDS_WS_OFF + NW * 64 * 4, LDS_BYTES = LDS_KM_OFF + 2 * 4096;
constexpr unsigned WBIG = 0x40000000u;

#define KSWZ(row, colB) ((row) * 256 + ((colB) ^ (((row) & 7) << 4)))
#define SBAR() __builtin_amdgcn_sched_barrier(0)
__device__ __forceinline__ int v_st(int k, int c) { const int kk = (k & ~0xC) | ((k & 4) << 1) | ((k & 8) >> 1); return ((kk >> 3) * 4 + (c >> 5)) * 512 + ((kk & 7) * 32 + (c & 31)) * 2; }
__device__ __forceinline__ int v_rd_base(int lane) { return ((lane & 3) << 3) | (((lane >> 2) & 3) << 6) | (((lane >> 4) & 1) << 5) | (((lane >> 5) & 1) << 8); }
constexpr int v_rd_off(int d0, int ks, int half) { return d0 * 512 + ks * 4096 + half * 2048; }
__device__ __forceinline__ int crow(int r, int hi) { return (r & 3) + 8 * (r >> 2) + 4 * hi; }
__device__ __forceinline__ unsigned cvtpk(float lo, float hi) { unsigned r; asm volatile("v_cvt_pk_bf16_f32 %0, %1, %2" : "=v"(r) : "v"(lo), "v"(hi)); return r; }
__device__ __forceinline__ bf16x8 load8(const bf16* p) { return *reinterpret_cast<const bf16x8*>(p); }
__device__ __forceinline__ void mask_tile(f32x16& p0, f32x16& p1, int dq, unsigned W) {
    const float NEG = -__builtin_inff();
#pragma unroll
    for (int r = 0; r < 16; ++r) {
        const int c = (r & 3) + 8 * (r >> 2);
        if ((unsigned)(dq - c) >= W) p0[r] = NEG;
        if ((unsigned)(dq - c - 32) >= W) p1[r] = NEG;
    }
}
__device__ __forceinline__ void mask_tile_post(f32x16& p0, f32x16& p1, int dq, unsigned W) {
    const float NEG = -__builtin_inff();
#pragma unroll
    for (int r = 0; r < 16; ++r) {
        const int c = (r & 3) + 8 * (r >> 2);
        if ((unsigned)(dq - c) >= W) p0[r] = 0.f;
        if ((unsigned)(dq - c - 32) >= W) p1[r] = NEG;
    }
}
__device__ __forceinline__ void partialSM(f32x16& p0, f32x16& p1, float& m_reg, float& mn, float& alpha) {
    float pmax = p0[0]; for (int r = 1; r < 16; ++r) pmax = fmaxf(pmax, p0[r]); for (int r = 0; r < 16; ++r) pmax = fmaxf(pmax, p1[r]);
    { auto rr = __builtin_amdgcn_permlane32_swap(__float_as_uint(pmax), __float_as_uint(pmax), false, false);
      pmax = fmaxf(__uint_as_float(rr[0]), __uint_as_float(rr[1])); }
    constexpr float C2 = 1.4426950408889634f * SCALE;
    if (__builtin_expect(__all((pmax - m_reg) * SCALE <= THR), 1)) { mn = m_reg; alpha = 1.f; }
    else { mn = fmaxf(m_reg, pmax); alpha = __builtin_amdgcn_exp2f((m_reg - mn) * C2); m_reg = mn; }
    const float mnL = -mn * C2;
    for (int r = 0; r < 16; ++r) p0[r] = fmaf(p0[r], C2, mnL); for (int r = 0; r < 16; ++r) p1[r] = fmaf(p1[r], C2, mnL);
    for (int r = 0; r < 16; ++r) p0[r] = __builtin_amdgcn_exp2f(p0[r]);
}
#ifndef ATT_FIXEDMAX
#define ATT_FIXEDMAX 1
#endif
__device__ __forceinline__ void partialSM_fixed(f32x16& p0, f32x16& p1) {
    for (int r = 0; r < 16; ++r) p0[r] = __builtin_amdgcn_exp2f(p0[r]);
}
__device__ __forceinline__ void finishSM(f32x16& p0, f32x16& p1, float alpha, float& l_reg, bf16x8& pa0, bf16x8& pa1, bf16x8& pa2, bf16x8& pa3) {
    for (int r = 0; r < 16; ++r) p1[r] = __builtin_amdgcn_exp2f(p1[r]);
    float ps = 0; for (int r = 0; r < 16; ++r) ps += p0[r]; for (int r = 0; r < 16; ++r) ps += p1[r];
    { auto rr = __builtin_amdgcn_permlane32_swap(__float_as_uint(ps), __float_as_uint(ps), false, false);
      ps = __uint_as_float(rr[0]) + __uint_as_float(rr[1]); }
    l_reg = l_reg * alpha + ps;
#define PK4(P, B_, OUT) do { unsigned a0 = cvtpk(P[B_+0], P[B_+1]), a1 = cvtpk(P[B_+2], P[B_+3]);                          \
        unsigned b0 = cvtpk(P[B_+4], P[B_+5]), b1 = cvtpk(P[B_+6], P[B_+7]);                                             \
        auto r0 = __builtin_amdgcn_permlane32_swap(a0, b0, false, false); auto r1 = __builtin_amdgcn_permlane32_swap(a1, b1, false, false); \
        u32x4 w = {r0[0], r1[0], r0[1], r1[1]}; OUT = *reinterpret_cast<bf16x8*>(&w); } while (0)
    PK4(p0, 0, pa0); PK4(p0, 8, pa1); PK4(p1, 0, pa2); PK4(p1, 8, pa3);
#undef PK4
}
template <int KB>
__device__ __forceinline__ void qkt(f32x16& p0, f32x16& p1, const char* K_lds, int r32, int hi, const bf16x8* qr, float cinit) {
#pragma unroll
    for (int r = 0; r < 16; ++r) { p0[r] = cinit; p1[r] = cinit; }
    const char* kb[4];
#pragma unroll
    for (int dd = 0; dd < 4; ++dd) kb[dd] = K_lds + KB * SHM_K + KSWZ(r32, (dd * 16 + hi * 8) * 2);
#pragma unroll
    for (int d0 = 0; d0 < 8; ++d0) { const char* a = kb[d0 & 3] + (d0 >> 2) * 128;
        bf16x8 b0 = *reinterpret_cast<const bf16x8*>(a);
        bf16x8 b1 = *reinterpret_cast<const bf16x8*>(a + 32 * 256);
        p0 = __builtin_amdgcn_mfma_f32_32x32x16_bf16(b0, qr[d0], p0, 0, 0, 0);
        p1 = __builtin_amdgcn_mfma_f32_32x32x16_bf16(b1, qr[d0], p1, 0, 0, 0); }
}
typedef short v4i16_t __attribute__((ext_vector_type(4)));
typedef __attribute__((address_space(3))) v4i16_t* lds_v4i16_ptr;
template <bool EXPS>
__device__ __forceinline__ void pv_tile(f32x16* o, int vb0, bf16x8 pa0, bf16x8 pa1, bf16x8 pa2, bf16x8 pa3, f32x16& px) {
    const __attribute__((address_space(3))) char* vp = (const __attribute__((address_space(3))) char*)(unsigned)vb0;
#define TRRD(off) __builtin_bit_cast(s16x4, __builtin_amdgcn_ds_read_tr16_b64_v4i16((lds_v4i16_ptr)(vp + (off))))
#define PV_RD(i, L, H) do { constexpr int o_ = v_rd_off((i) & 3, (i) >> 2, 0); L = TRRD(o_); H = TRRD(o_ + 2048); } while (0)
#define PV_PA(ks) ((ks) == 0 ? pa0 : (ks) == 1 ? pa1 : (ks) == 2 ? pa2 : pa3)
#define PV_STEP(i, L, H) do { o[(i) & 3] = __builtin_amdgcn_mfma_f32_32x32x16_bf16((bf16x8){L[0], L[1], L[2], L[3], H[0], H[1], H[2], H[3]}, PV_PA((i) >> 2), o[(i) & 3], 0, 0, 0);     \
        if ((i) + 4 < 16) PV_RD((i) + 4, L, H); if constexpr (EXPS) px[i] = __builtin_amdgcn_exp2f(px[i]); SBAR(); } while (0)
    s16x4 l0, h0, l1, h1, l2, h2, l3, h3;
    PV_RD(0, l0, h0); PV_RD(1, l1, h1); PV_RD(2, l2, h2); PV_RD(3, l3, h3); SBAR();
    PV_STEP(0, l0, h0); PV_STEP(1, l1, h1); PV_STEP(2, l2, h2); PV_STEP(3, l3, h3);
    PV_STEP(4, l0, h0); PV_STEP(5, l1, h1); PV_STEP(6, l2, h2); PV_STEP(7, l3, h3);
    PV_STEP(8, l0, h0); PV_STEP(9, l1, h1); PV_STEP(10, l2, h2); PV_STEP(11, l3, h3);
    PV_STEP(12, l0, h0); PV_STEP(13, l1, h1); PV_STEP(14, l2, h2); PV_STEP(15, l3, h3);
#undef PV_STEP
#undef PV_PA
#undef PV_RD
#undef TRRD
}

struct BlockRef { const bf16* Q; const bf16* K; const bf16* V; bf16* O; int P0, skv, moba_qb, kmi; float mnl; };
struct Seam { bf16x8 qr[8]; bf16x8 st_v0, st_v1, st_k0, st_k1; };
#define ROWP(p, k0, rr) ((p) + (size_t)((k0) + (rr)) * PKV + sc)
#define VMW() asm volatile("s_waitcnt vmcnt(0)" ::: "memory")
#define VMWN(n) asm volatile("s_waitcnt vmcnt(%0)" :: "i"(n) : "memory")
#define SLOAD_H(Kp, Vp, k0) do { S.st_v0 = load8(ROWP(Vp, k0, sr)); S.st_v1 = load8(ROWP(Vp, k0, 32 + sr));              \
                                 S.st_k0 = load8(ROWP(Kp, k0, sr)); S.st_k1 = load8(ROWP(Kp, k0, 32 + sr)); } while (0)
#define SWRITE_HK(bf) do { *(bf16x8*)(K_lds + (bf) * SHM_K + kws) = S.st_k0; *(bf16x8*)(K_lds + (bf) * SHM_K + kws + 32 * 256) = S.st_k1; } while (0)
#define SWRITE_HV(voff) do { *(bf16x8*)(V_lds + (voff) + vst0) = S.st_v0; *(bf16x8*)(V_lds + (voff) + vst1) = S.st_v1; } while (0)
#define SWRITE_H(kb, voff) do { SWRITE_HV(voff); SWRITE_HK(kb); } while (0)
template <int PQ, int PKV, int PO, bool MOBA>
__device__ __forceinline__ void attn_prime(const BlockRef& cur, char* lds, Seam& S) {
    const int tid = threadIdx.x, wid = __builtin_amdgcn_readfirstlane(tid >> 6), lane = tid & 63, r32 = lane & 31, hi = lane >> 5;
    const int sr = tid >> 4, sc = (tid & 15) * 8, kws = KSWZ(sr, sc * 2); char* K_lds = lds + NVB * SHM_V;
    for (int d0 = 0; d0 < 8; ++d0) S.qr[d0] = load8(cur.Q + (size_t)(wid * QBLK + r32) * PQ + d0 * 16 + hi * 8);
    SLOAD_H(cur.K, cur.V, 0);
    VMW(); SWRITE_HK(0);
    __syncthreads();
}
template <int PQ, int PKV, int PO, bool MOBA>
__device__ __forceinline__ void attn_block(const BlockRef& cur, const BlockRef& nxt, char* lds, Seam& S) {
    const int tid = threadIdx.x, wid = __builtin_amdgcn_readfirstlane(tid >> 6), lane = tid & 63, r32 = lane & 31, hi = lane >> 5;
    int j_hi = (cur.P0 + QB - 1) / KVBLK + 1; if (j_hi > cur.skv / KVBLK) j_hi = cur.skv / KVBLK;
    const int NT = j_hi;
    const int qlo = cur.P0 + wid * QBLK, qm = qlo + r32 - 4 * hi;
    const int qbm = MOBA ? cur.moba_qb : -1;
    char* V_lds = lds; char* K_lds = lds + NVB * SHM_V;
    float* ws = (float*)(lds + LDS_WS_OFF) + wid * 64; float* li_l = ws, * al_l = ws + 32;
    float m_reg = -1e30f, l_reg = 0; f32x16 o[4] = {};
    const int sr = tid >> 4, sc = (tid & 15) * 8, vst0 = v_st(sr, sc), vst1 = vst0 + 8192  , kws = KSWZ(sr, sc * 2);
    const int vb0 = (int)(uintptr_t)V_lds + v_rd_base(lane);
    const bf16* Kh = cur.K; const bf16* Vh = cur.V;
    unsigned sel = 0xffu;
    if (MOBA && qbm > 3) {
        const float* km = (const float*)(lds + LDS_KM_OFF) + cur.kmi * 1024 + hi * 8;
        const float NEGI = -__builtin_inff();
        float v1 = NEGI, v2 = NEGI, v3 = NEGI; unsigned b1 = 0u, b2 = 0u, b3 = 0u;
#pragma unroll 1
        for (int j = 0; j < qbm; ++j) {
            float a = 0.f;
#pragma unroll
            for (int d0 = 0; d0 < 8; ++d0) {
                const f32x4 k0 = *(const f32x4*)(km + j * 128 + d0 * 16), k1 = *(const f32x4*)(km + j * 128 + d0 * 16 + 4);
                const bf16x8 q = S.qr[d0];
#pragma unroll
                for (int e = 0; e < 4; ++e) { a = fmaf(__uint_as_float((unsigned)(unsigned short)q[e] << 16), k0[e], a); }
#pragma unroll
                for (int e = 0; e < 4; ++e) { a = fmaf(__uint_as_float((unsigned)(unsigned short)q[4 + e] << 16), k1[e], a); }
            }
            a += __shfl_xor(a, 32);
            const unsigned bj = 1u << j;
            const bool g1 = a > v1, g2 = a > v2, g3 = a > v3;
            v3 = g2 ? v2 : (g3 ? a : v3); b3 = g2 ? b2 : (g3 ? bj : b3);
            v2 = g1 ? v1 : (g2 ? a : v2); b2 = g1 ? b1 : (g2 ? bj : b2);
            v1 = g1 ? a : v1;             b1 = g1 ? bj : b1;
        }
        sel = b1 | b2 | b3;
    }
#if ATT_FIXEDMAX
#define PSM(P0_, P1_, mn_, al_) do { partialSM_fixed(P0_, P1_); al_ = 1.f; } while (0)
#define RESC(a) do { } while (0)
#else
#define PSM(P0_, P1_, mn_, al_) partialSM(P0_, P1_, m_reg, mn_, al_)
#define RESC(a) do { if (__any((a) < 1.f)) { if (hi == 0) al_l[r32] = (a); asm volatile("s_waitcnt lgkmcnt(0)" ::: "memory");              \
                     for (int d_ = 0; d_ < 4; ++d_) for (int r = 0; r < 16; ++r) o[d_][r] *= al_l[crow(r, hi)]; } } while (0)
#endif
#define KBASE(t) ((t) * KVBLK)
#define MASKT(P0_, P1_, t) do { const int kb_ = KBASE(t); if (kb_ + KVBLK - 1 > qlo) mask_tile(P0_, P1_, qm - kb_, WBIG); } while (0)
#define CINIT(t) (((MOBA && ((t) >> 2) < qbm && !((sel >> ((t) >> 2)) & 1u)) ? -__builtin_inff() : 0.f) + (ATT_FIXEDMAX ? cur.mnl : 0.f))
    constexpr int NQL = 8;
#define SEAM_K0() do { VMWN(NQL); SWRITE_HK(0); SBAR(); } while (0)
    f32x16 pA0, pA1, pB0, pB1; float mnA, mnB, alA, alB; bf16x8 pa0, pa1, pa2, pa3;
    SWRITE_HV(0); SBAR();
    if (NT > 1) { SLOAD_H(Kh, Vh, KBASE(1)); }
    SBAR(); qkt<0>(pA0, pA1, K_lds, r32, hi, S.qr, CINIT(0));
    MASKT(pA0, pA1, 0); PSM(pA0, pA1, mnA, alA);
    if (NT > 1) { VMW(); SWRITE_H(1, SHM_V); }
    __syncthreads();
    int vA = 0, vB = SHM_V, vC = 2 * SHM_V;
#define HALF_STEP(PX0, PX1, mnX, alX, PY0, PY1, alY, t, KB, SB) do {                                                             \
        SBAR(); if ((t) + 1 < NT) { SLOAD_H(Kh, Vh, KBASE((t) + 1)); SBAR(); }     \
        qkt<KB>(PX0, PX1, K_lds, r32, hi, S.qr, CINIT(t));                                                                    \
        finishSM(PY0, PY1, alY, l_reg, pa0, pa1, pa2, pa3); SBAR();                                                           \
        pv_tile<ATT_FIXEDMAX != 0>(o, vb0 + vA, pa0, pa1, pa2, pa3, PX0);     \
        if (ATT_FIXEDMAX) { const int kb_ = KBASE(t); if (kb_ + KVBLK - 1 > qlo) mask_tile_post(PX0, PX1, qm - kb_, WBIG); alX = 1.f; } else { MASKT(PX0, PX1, (t)); PSM(PX0, PX1, mnX, alX); }   \
          \
        if ((t) + 1 < NT) { VMW(); SWRITE_H(SB, vC); }                                                                        \
        RESC(alX); { const int v_ = vA; vA = vB; vB = vC; vC = v_; } __syncthreads(); } while (0)
    for (int t = 1; t + 1 < NT; t += 2) {
        HALF_STEP(pB0, pB1, mnB, alB, pA0, pA1, alA, t, 1, 0);
        HALF_STEP(pA0, pA1, mnA, alA, pB0, pB1, alB, t + 1, 0, 1);
    }
    const bool even = (NT & 1) == 0;
    if (even) { SBAR(); qkt<1>(pB0, pB1, K_lds, r32, hi, S.qr, CINIT(NT - 1)); SBAR(); }
    SLOAD_H(nxt.K, nxt.V, 0); SBAR();
#pragma unroll
    for (int d0 = 0; d0 < 8; ++d0) S.qr[d0] = load8(nxt.Q + (size_t)(wid * QBLK + r32) * PQ + d0 * 16 + hi * 8);
    SBAR();
    finishSM(pA0, pA1, alA, l_reg, pa0, pa1, pa2, pa3); SBAR();
    pv_tile<false>(o, vb0 + vA, pa0, pa1, pa2, pa3, pA0);
    if (even) { MASKT(pB0, pB1, NT - 1); PSM(pB0, pB1, mnB, alB); __syncthreads(); RESC(alB);
        finishSM(pB0, pB1, alB, l_reg, pa0, pa1, pa2, pa3); SBAR(); pv_tile<false>(o, vb0 + vB, pa0, pa1, pa2, pa3, pB0); }
    SBAR(); SEAM_K0();
    const float rl_ = __builtin_amdgcn_rcpf(l_reg);
    int wq_ = wid; asm volatile("" : "+s"(wq_));
    unsigned loff_ = (unsigned)(r32 * PO) * 2u + (unsigned)hi * 16u; asm volatile("" : "+v"(loff_));
    char* Ob = (char*)(cur.O + (size_t)(wq_ * QBLK) * PO);
#pragma unroll
    for (int d0 = 0; d0 < 4; ++d0)
#pragma unroll
        for (int g = 0; g < 4; g += 2) {
            unsigned ax = cvtpk(o[d0][4 * g] * rl_, o[d0][4 * g + 1] * rl_), ay = cvtpk(o[d0][4 * g + 2] * rl_, o[d0][4 * g + 3] * rl_);
            unsigned bx = cvtpk(o[d0][4 * g + 4] * rl_, o[d0][4 * g + 5] * rl_), by = cvtpk(o[d0][4 * g + 6] * rl_, o[d0][4 * g + 7] * rl_);
            { auto r0 = __builtin_amdgcn_permlane32_swap(ax, bx, false, false); ax = r0[0]; bx = r0[1]; }
            { auto r1 = __builtin_amdgcn_permlane32_swap(ay, by, false, false); ay = r1[0]; by = r1[1]; }
            u32x4 w = {ax, ay, bx, by};
            *(u32x4*)(Ob + (d0 * 32 + 8 * g) * 2 + loff_) = w; }
    __syncthreads();
#undef RESC
#undef PSM
#undef KBASE
#undef MASKT
#undef CINIT
#undef SEAM_K0
#undef HALF_STEP
}
#undef ROWP
#undef VMW
#undef VMWN
#undef SLOAD_H
#undef SWRITE_HK
#undef SWRITE_HV
#undef SWRITE_H
#undef KSWZ
#undef SBAR
}

#define GAS __attribute__((address_space(1)))
#define LAS __attribute__((address_space(3)))
typedef unsigned short bf16;
typedef unsigned v4u __attribute__((ext_vector_type(4)));
typedef float f32x4 __attribute__((ext_vector_type(4)));
typedef short bf16x8 __attribute__((ext_vector_type(8)));
typedef GAS unsigned gu32;
typedef GAS unsigned long long gu64;
#define RLX_AGENT __ATOMIC_RELAXED, __HIP_MEMORY_SCOPE_AGENT
#define LDS_WAIT() asm volatile("s_waitcnt lgkmcnt(0)" ::: "memory")
#define VM_WAIT() asm volatile("s_waitcnt vmcnt(0)" ::: "memory")
__device__ __forceinline__ unsigned long long rt() { return __builtin_amdgcn_s_memrealtime(); }
__device__ __forceinline__ unsigned f2bf(float f) { unsigned u = __builtin_bit_cast(unsigned, f); return (u + 0x7fffu + ((u >> 16) & 1u)) >> 16; }
__device__ __forceinline__ unsigned pk2(float lo, float hi) { return f2bf(lo) | (f2bf(hi) << 16); }

#define XB_TMO      128
#define XB_XCNT(j)  (256  + 64 * (j))
#define XB_XSUB(j)  (1280 + 64 * (j))
#define XB_XGEN(j)  (2304 + 64 * (j))
#define XB_TOP      3328
#define XB_TOPGEN   3392
#define XCD_BAR_WORDS 3456
#define XB_SPIN_CAP (1u << 18)

__device__ __forceinline__ unsigned xb_ld(unsigned* p)              { return __hip_atomic_load(p, __ATOMIC_RELAXED, __HIP_MEMORY_SCOPE_AGENT); }
__device__ __forceinline__ unsigned xb_add(unsigned* p, unsigned v) { return __hip_atomic_fetch_add(p, v, __ATOMIC_RELAXED, __HIP_MEMORY_SCOPE_AGENT); }
__device__ __forceinline__ unsigned xb_xcc_id() { return (unsigned)__builtin_amdgcn_s_getreg((3 << 11) | 20) & 0xFu; }
#define XB_SPIN(cond, bar) do { unsigned _sp = 0; while (cond) { __builtin_amdgcn_s_sleep(1); \
    if ((++_sp & 255u) == 0u) { if (xb_ld(&(bar)[XB_TMO])) break; if (_sp > XB_SPIN_CAP) { atomicAdd(&(bar)[XB_TMO], 1u); break; } } } } while (0)

struct XcdBarrier {
    unsigned* bar; unsigned x;
    volatile LAS unsigned* st;
};

__device__ __forceinline__ XcdBarrier xcd_barrier_post(unsigned* bar, volatile LAS unsigned* st) {
    XcdBarrier b; b.bar = bar; b.x = xb_xcc_id(); b.st = st;
    if (threadIdx.x == 0) (void)xb_add(&bar[XB_XCNT(b.x)], 1u);
    return b;
}
__device__ __forceinline__ void xcd_barrier_complete(unsigned* bar, unsigned x, unsigned& nloc, unsigned& nx) {
    const unsigned G = gridDim.x * gridDim.y * gridDim.z;
    unsigned sum, cnt, mine, sp = 0u;
    for (;;) {
        sum = 0u; cnt = 0u; mine = 0u;
#pragma unroll
        for (unsigned j = 0; j < 16; ++j) { const unsigned c = xb_ld(&bar[XB_XCNT(j)]); sum += c; cnt += (c > 0u) ? 1u : 0u; mine = (j == x) ? c : mine; }
        if (sum == G) break;
        __builtin_amdgcn_s_sleep(1);
        if ((++sp & 255u) == 0u) { if (xb_ld(&bar[XB_TMO])) break; if (sp > XB_SPIN_CAP) { atomicAdd(&bar[XB_TMO], 1u); break; } }
    }
    nloc = mine > 0u ? mine : 1u; nx = cnt > 0u ? cnt : 1u;
}

__device__ __forceinline__ void xcd_barrier(const XcdBarrier& b) {
    asm volatile("s_waitcnt vmcnt(0)" ::: "memory");
    __syncthreads();
    if (threadIdx.x == 0) {
        unsigned* bar = b.bar;
        __builtin_amdgcn_s_waitcnt(0);
        unsigned nloc = b.st[0], nx = b.st[1];
        if (nloc == 0u) { xcd_barrier_complete(bar, b.x, nloc, nx); b.st[0] = nloc; b.st[1] = nx; }
        const unsigned old = xb_add(&bar[XB_XSUB(b.x)], 1u);
        const unsigned gen = old / nloc;
        if (old + 1u == (gen + 1u) * nloc) {
            __builtin_amdgcn_fence(__ATOMIC_RELEASE, "agent");
            asm volatile("s_waitcnt vmcnt(0)" ::: "memory");
            const unsigned og = xb_add(&bar[XB_TOP], 1u);
            const unsigned tg = og / nx;
            if (og + 1u == (tg + 1u) * nx) xb_add(&bar[XB_TOPGEN], 1u);
            else XB_SPIN(xb_ld(&bar[XB_TOPGEN]) == tg, bar);
            __builtin_amdgcn_fence(__ATOMIC_ACQUIRE, "agent");
            xb_add(&bar[XB_XGEN(b.x)], 1u);
            asm volatile("s_waitcnt vmcnt(0)" ::: "memory");
        } else {
            XB_SPIN(xb_ld(&bar[XB_XGEN(b.x)]) == gen, bar);
            __builtin_amdgcn_fence(__ATOMIC_ACQUIRE, "agent");
            asm volatile("s_waitcnt vmcnt(0)" ::: "memory");
        }
    }
    __syncthreads();
}


constexpr int NWAVES = 8;
#ifndef MK_N_LAUNCHES
#define MK_N_LAUNCHES 1
#endif
constexpr int NPH = 14;
constexpr int N_LAUNCHES = MK_N_LAUNCHES;
static_assert(N_LAUNCHES == 1 || N_LAUNCHES == NPH, "MK_N_LAUNCHES is 1 or NPH");

constexpr int BATCH = 8, SEQ = 2048, DM = 4096, M = BATCH * SEQ;
constexpr int NIN = 12288, FF = 11008, NGU = 2 * FF, MEML = 256, MM = BATCH * MEML, MW = 512, NKV = 2 * MW;
constexpr int C_QA = 0, C_KA = 2048, C_VA = 4096, C_QB = 6144, C_KB = 8192, C_VB = 10240;
constexpr float NORM_EPS = 1e-6f;
constexpr float LAM_INIT = 0.2f;

constexpr size_t MiB = 1u << 20;
constexpr size_t WS_CTL = 0, CTL_ZERO_BYTES = 64 * 1024;
constexpr size_t WS_ROPE = 1 * MiB;
constexpr size_t WS_KMEAN = WS_ROPE + 512 * 1024;
constexpr size_t WS_W_IN = 2 * MiB;
constexpr size_t WS_W_OUT = WS_W_IN + (size_t)NIN * DM * 2;
constexpr size_t WS_W_MQ = WS_W_OUT + (size_t)DM * DM * 2;
constexpr size_t WS_W_MKV = WS_W_MQ + (size_t)MW * DM * 2;
constexpr size_t WS_W_MO = WS_W_MKV + (size_t)NKV * DM * 2;
constexpr size_t WS_W_GU = WS_W_MO + (size_t)DM * MW * 2;
constexpr size_t WS_W_DN = WS_W_GU + (size_t)NGU * DM * 2;
constexpr size_t WS_XN = WS_W_DN + (size_t)DM * FF * 2;
constexpr size_t WS_PROJ = WS_XN + (size_t)M * DM * 2;
constexpr size_t WS_MIX = WS_PROJ + (size_t)M * NIN * 2;
constexpr size_t WS_MEMN = WS_MIX + (size_t)M * DM * 2;
constexpr size_t WS_KVC = WS_MEMN + (size_t)MM * DM * 2;
constexpr size_t WS_PS = WS_KVC + (size_t)MM * NKV * 2;
constexpr size_t WS_RS = WS_PS + (size_t)2 * M * 64 * 4;
constexpr size_t WS_END = WS_RS + (size_t)2 * M * 4;
static_assert(WS_W_IN % MiB == 0 && WS_XN % 256 == 0 && WS_END <= 1140000000ull, "d_ws map");
constexpr int CW_TMO = 0, CW_CODE = 1;
constexpr int CW_BAR = 4096;
static_assert((CW_BAR + 2 * XCD_BAR_WORDS) * 4 <= (int)CTL_ZERO_BYTES, "both barrier regions inside the per-call memset");

constexpr int RING_OFF = 0, RING_BYTES = 131072;
constexpr int LDSCTL_OFF = RING_BYTES, MISC_OFF = LDSCTL_OFF + 320;
constexpr int EPIX_OFF = MISC_OFF + 128;
constexpr int LDS_BYTES = 147456;
static_assert(EPIX_OFF % 16 == 0 && EPIX_OFF + 12288 <= LDS_BYTES && att::LDS_BYTES <= RING_BYTES, "LDS map");

__device__ __forceinline__ float wave_sum(float v) {
#pragma unroll
    for (int o = 1; o < 64; o <<= 1) v += __shfl_xor(v, o);
    return v;
}
__device__ __forceinline__ float bf2f(unsigned short s) { return __uint_as_float((unsigned)s << 16); }
__device__ __forceinline__ void p0_transpose_item(const float* W, int K, int N, bf16* WT, int k0, int n0, int orow0, LAS float* scr, int lane, const float* gk = nullptr, bool pd = false) {
    const int lr = lane >> 4, n4 = lane & 15;
    f32x4 v[16];
#pragma unroll
    for (int i = 0; i < 16; ++i) v[i] = *(const GAS f32x4*)(W + (size_t)(k0 + 4 * i + lr) * N + n0 + 4 * n4);
    const int c = lane & 7, nn = lane >> 3;
    f32x4 ga = {1.f, 1.f, 1.f, 1.f}, gb = {1.f, 1.f, 1.f, 1.f};
    if (gk) { ga = *(const f32x4*)(gk + k0 + 8 * c); gb = *(const f32x4*)(gk + k0 + 8 * c + 4); }
#pragma unroll
    for (int i = 0; i < 16; ++i) { const int k = 4 * i + lr; *(LAS f32x4*)(scr + k * 64 + ((4 * n4) ^ (((k >> 3) & 7) << 2))) = v[i]; }
    LDS_WAIT(); asm volatile("" ::: "memory");
#pragma unroll
    for (int j = 0; j < 8; ++j) { const int n = nn + 8 * j; const LAS float* s = scr + (8 * c) * 64 + (n ^ (c << 2));
        v4u o; o.x = pk2(s[0 * 64] * ga.x, s[1 * 64] * ga.y); o.y = pk2(s[2 * 64] * ga.z, s[3 * 64] * ga.w); o.z = pk2(s[4 * 64] * gb.x, s[5 * 64] * gb.y); o.w = pk2(s[6 * 64] * gb.z, s[7 * 64] * gb.w);
        const int orow = pd ? ((orow0 + n) & ~127) + pg8::rope_slot((orow0 + n) & 127) : orow0 + n;
        *(GAS v4u*)(WT + (size_t)orow * K + k0 + 8 * c) = o; }
    LDS_WAIT(); asm volatile("" ::: "memory");
}
__device__ __forceinline__ void rms_row_to_bf16(const float* xrow, const float* g, bf16* orow, int lane) {
    const GAS f32x4* xr = (const GAS f32x4*)xrow + lane; const GAS f32x4* gr = (const GAS f32x4*)g + lane;
    f32x4 v[16]; float s = 0.f;
#pragma unroll
    for (int j = 0; j < 16; ++j) { v[j] = xr[64 * j]; s += (v[j].x * v[j].x + v[j].y * v[j].y) + (v[j].z * v[j].z + v[j].w * v[j].w); }
    const float rs = 1.0f / sqrtf(wave_sum(s) * (1.f / DM) + NORM_EPS);
    GAS unsigned long long* o8 = (GAS unsigned long long*)orow + lane;
#pragma unroll
    for (int j = 0; j < 16; ++j) { const f32x4 gg = gr[64 * j];
        o8[64 * j] = (unsigned long long)pk2(v[j].x * rs * gg.x, v[j].y * rs * gg.y) | ((unsigned long long)pk2(v[j].z * rs * gg.z, v[j].w * rs * gg.w) << 32); }
}
__device__ __forceinline__ void normrope_unit(bf16* T, int pitch, int row0, int c0, const float* g, const float* rope, float* km, LAS float* scr, int tid) {
    const int wave = tid >> 6, lane = tid & 63, rsub = lane >> 4, c = lane & 15;
    float gv[8];
    { const f32x4 g0 = *(const f32x4*)(g + 8 * c), g1 = *(const f32x4*)(g + 8 * c + 4); gv[0] = g0.x; gv[1] = g0.y; gv[2] = g0.z; gv[3] = g0.w; gv[4] = g1.x; gv[5] = g1.y; gv[6] = g1.z; gv[7] = g1.w; }
    float csum[8];
#pragma unroll
    for (int e = 0; e < 8; ++e) csum[e] = 0.f;
#pragma unroll 2
    for (int it = 0; it < 8; ++it) {
        const int r = row0 + wave * 32 + it * 4 + rsub;
        bf16* p = T + (size_t)r * pitch + c0 + 8 * c;
        const v4u raw = *(const v4u*)p;
        float y[8];
        y[0] = __uint_as_float(raw.x << 16); y[1] = __uint_as_float(raw.x & 0xffff0000u); y[2] = __uint_as_float(raw.y << 16); y[3] = __uint_as_float(raw.y & 0xffff0000u);
        y[4] = __uint_as_float(raw.z << 16); y[5] = __uint_as_float(raw.z & 0xffff0000u); y[6] = __uint_as_float(raw.w << 16); y[7] = __uint_as_float(raw.w & 0xffff0000u);
        float ss = 0.f;
#pragma unroll
        for (int e = 0; e < 8; ++e) ss += y[e] * y[e];
        ss += __shfl_xor(ss, 1); ss += __shfl_xor(ss, 2); ss += __shfl_xor(ss, 4); ss += __shfl_xor(ss, 8);
        const float rs = 1.0f / sqrtf(ss * (1.f / 128.f) + NORM_EPS);
#pragma unroll
        for (int e = 0; e < 8; ++e) y[e] = y[e] * rs * gv[e];
        if (rope) {
            float pr[8];
#pragma unroll
            for (int e = 0; e < 8; ++e) pr[e] = __shfl_xor(y[e], 2);
            if (c < 4) {
                const float* cs = rope + (size_t)(r & (SEQ - 1)) * 32 + (c & 1) * 8;
                const f32x4 c0v = *(const f32x4*)cs, c1v = *(const f32x4*)(cs + 4), s0v = *(const f32x4*)(cs + 16), s1v = *(const f32x4*)(cs + 20);
                const float cc[8] = {c0v.x, c0v.y, c0v.z, c0v.w, c1v.x, c1v.y, c1v.z, c1v.w}, sn[8] = {s0v.x, s0v.y, s0v.z, s0v.w, s1v.x, s1v.y, s1v.z, s1v.w};
                const float sg = (c < 2) ? -1.f : 1.f;
#pragma unroll
                for (int e = 0; e < 8; ++e) y[e] = y[e] * cc[e] + sg * pr[e] * sn[e];
            }
        }
#pragma unroll
        for (int e = 0; e < 8; ++e) csum[e] += y[e];
        v4u o; o.x = pk2(y[0], y[1]); o.y = pk2(y[2], y[3]); o.z = pk2(y[4], y[5]); o.w = pk2(y[6], y[7]);
        *(v4u*)p = o;
    }
    if (km) {
#pragma unroll
        for (int e = 0; e < 8; ++e) { csum[e] += __shfl_xor(csum[e], 16); csum[e] += __shfl_xor(csum[e], 32); }
        if (rsub == 0) {
#pragma unroll
            for (int e = 0; e < 8; ++e) scr[wave * 128 + 8 * c + e] = csum[e]; }
        __syncthreads();
        if (tid < 128) { float s = 0.f;
#pragma unroll
            for (int w = 0; w < 8; ++w) s += scr[w * 128 + tid];
            km[tid] = s * (1.f / 256.f); }
        __syncthreads();
    }
}


__device__ __forceinline__ bf16* hm_addr(bf16* T, int ch, int b, int s) { return T + ((size_t)(ch * BATCH + b) * SEQ + s) * 128; }
__device__ __forceinline__ float att_mnl(const float* gq, const float* gk, int lane) {
    float a = fmaxf(fabsf(gq[lane]), fabsf(gq[lane + 64])), b = fmaxf(fabsf(gk[lane]), fabsf(gk[lane + 64]));
#pragma unroll
    for (int o = 1; o < 64; o <<= 1) { a = fmaxf(a, __shfl_xor(a, o)); b = fmaxf(b, __shfl_xor(b, o)); }
    return __int_as_float(__builtin_amdgcn_readfirstlane(__float_as_int(-(128.0f * a * b * 1.03f) * (1.4426950408889634f * att::SCALE))));
}
__device__ __forceinline__ att::BlockRef attn_get(int idx, int G, int vcu, bf16* PROJ_, bf16* MIX_, bf16* DO_, float mnl_diff, float mnl_moba) {
    att::BlockRef r;
    if (idx < 8) { const int b = vcu >> 5, dh = (vcu >> 2) & 7, xq = vcu & 3, pass = idx >> 2, sub = idx & 3, s = sub >> 1, vh = (sub & 1) ^ s, qb = pass ? 7 - xq : xq;
        const size_t rq = (size_t)b * SEQ + (size_t)qb * 256;
        r.Q = hm_addr(PROJ_, 48 + 2 * dh + s, b, qb * 256); r.K = hm_addr(PROJ_, 64 + 2 * dh + s, b, 0); r.V = hm_addr(PROJ_, 80 + 2 * dh + vh, b, 0);
        r.O = DO_ + rq * DM + dh * 512 + s * 256 + vh * 128; r.moba_qb = -1; r.kmi = 0; r.P0 = qb * 256; r.mnl = mnl_diff; }
    else { const int mi = (idx - 8) >> 1, pass = idx & 1, I = mi * G + vcu, xq = I & 3, hm = I >> 2, b = hm >> 4, hu = hm & 15, qb = pass ? 7 - xq : xq;
        const size_t rq = (size_t)b * SEQ + (size_t)qb * 256;
        r.Q = hm_addr(PROJ_, hu, b, qb * 256); r.K = hm_addr(PROJ_, 16 + hu, b, 0); r.V = hm_addr(PROJ_, 32 + hu, b, 0); r.O = MIX_ + rq * DM + hu * 128;
        r.moba_qb = qb; r.kmi = mi; r.P0 = qb * 256; r.mnl = mnl_moba; }
    r.skv = SEQ;
    return r;
}

struct Args { const float* in[26]; float* out; float* outw; unsigned char* ws; int ph_lo, ph_hi, li, pad; };
#define KAS __attribute__((address_space(4)))
__device__ __forceinline__ const KAS Args* kargs() { const KAS Args* p = (const KAS Args*)__builtin_amdgcn_kernarg_segment_ptr(); asm volatile("" : "+s"(p)); return p; }
#define KARGS (kargs())
#define A_IN(k) (KARGS->in[k])
#define PS_CROSS ((float*)(ws + WS_PS))
#define PS_FFN ((float*)(ws + WS_PS) + (size_t)M * 64)
#define RS_CROSS ((float*)(ws + WS_RS))
#define RS_FFN ((float*)(ws + WS_RS) + M)
#define ROPE ((float*)(ws + WS_ROPE))
#define KMEAN ((float*)(ws + WS_KMEAN))
#define W_IN ((bf16*)(ws + WS_W_IN))
#define W_OUT ((bf16*)(ws + WS_W_OUT))
#define W_MQ ((bf16*)(ws + WS_W_MQ))
#define W_MKV ((bf16*)(ws + WS_W_MKV))
#define W_MO ((bf16*)(ws + WS_W_MO))
#define W_GU ((bf16*)(ws + WS_W_GU))
#define W_DN ((bf16*)(ws + WS_W_DN))
#define XN ((bf16*)(ws + WS_XN))
#define PROJ ((bf16*)(ws + WS_PROJ))
#define MIX ((bf16*)(ws + WS_MIX))
#define MEMN ((bf16*)(ws + WS_MEMN))
#define KVC ((bf16*)(ws + WS_KVC))
#define DO XN
#define HB PROJ
#define QC MIX
#define OC (MIX + (size_t)16 * MiB / 2)

constexpr int CV_I_IN = (DM / 64) * (NIN / 64), CV_I_OUT = (DM / 64) * (DM / 64), CV_I_MQ = (DM / 64) * (MW / 64), CV_I_MO = (MW / 64) * (DM / 64), CV_I_G = (DM / 64) * (FF / 64), CV_I_DN = (FF / 64) * (DM / 64);
constexpr int CV_S_GU = CV_I_IN + CV_I_OUT + 3 * CV_I_MQ + CV_I_MO, CV_S_DN = CV_S_GU + 2 * CV_I_G, CV_NITEMS = CV_S_DN + CV_I_DN;
constexpr int CV_GU_P7 = 96 * 8 * 9, CV_DN_P12 = 128 * 8 * 10;
constexpr int CV_P0_A = CV_S_DN - CV_GU_P7, CV_DN_P0 = CV_I_DN - CV_DN_P12;
static_assert(CV_P0_A > CV_S_GU && CV_DN_P0 >= 0, "conversion split");
__device__ __forceinline__ void convert_item(int it, unsigned char* ws, LAS float* scr, int lane) {
    int r = it;
    if (r < CV_I_IN) { const int nb = NIN / 64, kb = r / nb, n0 = 64 * (r % nb); p0_transpose_item(A_IN(3), DM, NIN, W_IN, 64 * kb, n0, n0, scr, lane, nullptr, pg8::PolProj::kind(n0 >> 8) >= 2); return; } r -= CV_I_IN;
    if (r < CV_I_OUT) { const int nb = DM / 64, kb = r / nb, n0 = 64 * (r % nb); p0_transpose_item(A_IN(13), DM, DM, W_OUT, 64 * kb, n0, n0, scr, lane); return; } r -= CV_I_OUT;
    if (r < CV_I_MQ) { const int nb = MW / 64, kb = r / nb, n0 = 64 * (r % nb); p0_transpose_item(A_IN(16), DM, MW, W_MQ, 64 * kb, n0, n0, scr, lane, A_IN(14)); return; } r -= CV_I_MQ;
    if (r < CV_I_MQ) { const int nb = MW / 64, kb = r / nb, n0 = 64 * (r % nb); p0_transpose_item(A_IN(17), DM, MW, W_MKV, 64 * kb, n0, n0, scr, lane); return; } r -= CV_I_MQ;
    if (r < CV_I_MQ) { const int nb = MW / 64, kb = r / nb, n0 = 64 * (r % nb); p0_transpose_item(A_IN(18), DM, MW, W_MKV, 64 * kb, n0, MW + n0, scr, lane); return; } r -= CV_I_MQ;
    if (r < CV_I_MO) { const int nb = DM / 64, kb = r / nb, n0 = 64 * (r % nb); p0_transpose_item(A_IN(19), MW, DM, W_MO, 64 * kb, n0, n0, scr, lane); return; } r -= CV_I_MO;
    if (r < CV_I_G) { const int nb = FF / 64, kb = r / nb, n0 = 64 * (r % nb); p0_transpose_item(A_IN(23), DM, FF, W_GU, 64 * kb, n0, 256 * (n0 / 128) + (n0 % 128), scr, lane, A_IN(22)); return; } r -= CV_I_G;
    if (r < CV_I_G) { const int nb = FF / 64, kb = r / nb, n0 = 64 * (r % nb); p0_transpose_item(A_IN(24), DM, FF, W_GU, 64 * kb, n0, 256 * (n0 / 128) + 128 + (n0 % 128), scr, lane, A_IN(22)); return; } r -= CV_I_G;
    { const int nb = DM / 64, kb = r / nb, n0 = 64 * (r % nb); p0_transpose_item(A_IN(25), FF, DM, W_DN, 64 * kb, n0, n0, scr, lane); }
}
#ifndef STAGGER_STEP
#define STAGGER_STEP 6
#endif
__device__ __forceinline__ void phase_stagger(int vcu) { for (int i = 0; i < (vcu & 31); ++i) __builtin_amdgcn_s_sleep(STAGGER_STEP); }
__device__ __forceinline__ void rs_panel(const float* PS, float* RS, int pm, int tid) {
    const int row = pm * 256 + (tid >> 1), half = tid & 1;
    const f32x4* p = (const f32x4*)(PS + (size_t)row * 64 + half * 32);
    float s = 0.f;
#pragma unroll
    for (int j = 0; j < 8; ++j) { const f32x4 v = p[j]; s += (v.x + v.y) + (v.z + v.w); }
    s += __shfl_xor(s, 1);
    if (!half) RS[row] = 1.0f / sqrtf(s * (1.f / DM) + NORM_EPS);
}
__global__ void __launch_bounds__(NWAVES * 64, 2) mk_fwd(Args args_unused) {
    extern __shared__ __attribute__((aligned(16))) unsigned char lds[];
    LAS unsigned char* const ldsL = (LAS unsigned char*)lds;
    volatile LAS unsigned* const MISC = (volatile LAS unsigned*)(ldsL + MISC_OFF);
    const int tid = threadIdx.x, lane = tid & 63, wave = __builtin_amdgcn_readfirstlane(tid >> 6);
    const int G = gridDim.x, bx = blockIdx.x, vcu = (G % 8 == 0) ? (bx % 8) * (G / 8) + bx / 8 : bx;
    unsigned char* const ws = KARGS->ws;
    gu32* const ctl = (gu32*)(ws + WS_CTL);
#define XIN (A_IN(0))
#define OUTR (KARGS->out)
#define OUTW (KARGS->outw)
    for (int u = tid; u < (LDS_BYTES - LDSCTL_OFF) / 4; u += NWAVES * 64) ((LAS unsigned*)(ldsL + LDSCTL_OFF))[u] = 0u;
    __syncthreads();
    XcdBarrier bar; bar.bar = (unsigned*)(ctl + CW_BAR) + KARGS->li * XCD_BAR_WORDS; bar.x = 0; bar.st = nullptr;
    if (N_LAUNCHES == 1) bar = xcd_barrier_post((unsigned*)(ctl + CW_BAR) + KARGS->li * XCD_BAR_WORDS, MISC + 8);
#define GRID_BAR(seam) do { if (N_LAUNCHES != 1) { if (tid == 0) __hip_atomic_store(ctl + CW_TMO, 0xBADBA0u | (unsigned)(seam), RLX_AGENT); } else { xcd_barrier(bar); } } while (0)
    const int lo = KARGS->ph_lo, hi = KARGS->ph_hi;
#ifndef PH_MASK
#define PH_MASK 0x3fff
#endif
#define IN(k) ((((PH_MASK) >> (k)) & 1) && lo <= (k) && (k) < hi)
#define BOTH(k) (IN(k) && IN((k) + 1))
    const int gw = vcu * NWAVES + wave, NGW = G * NWAVES;

    if (IN(0)) {
        LAS float* scr = (LAS float*)(ldsL + RING_OFF + wave * 16384);
        for (int it = gw; it < CV_P0_A; it += NGW) convert_item(it, ws, scr, lane);
        for (int it = CV_S_DN + gw; it < CV_S_DN + CV_DN_P0; it += NGW) convert_item(it, ws, scr, lane);
        for (int m = gw; m < M; m += NGW) rms_row_to_bf16(XIN + (size_t)m * DM, A_IN(2), XN + (size_t)m * DM, lane);
        for (int m = gw; m < MM; m += NGW) rms_row_to_bf16(A_IN(1) + (size_t)m * DM, A_IN(15), MEMN + (size_t)m * DM, lane);
        if (BOTH(0)) GRID_BAR(0);
    }
    if (IN(1)) {
        pg8::Gemm g{XN, W_IN, M, NIN, DM}; pg8::StaticOrder S; S.init(M, NIN, G, bx);
        { LAS float* gt = (LAS float*)(ldsL + EPIX_OFF + 10240); const int k = tid >> 7; const float* gsrc = k == 0 ? A_IN(4) : k == 1 ? A_IN(5) : k == 2 ? A_IN(6) : A_IN(7); gt[tid] = gsrc[tid & 127]; __syncthreads(); }
#ifdef PROBE_KMAX
        pg8::EpiHeads<pg8::PolProj> E{PROJ, KMEAN, (const float*)(size_t)(KARGS->li ? PROBE_KMAX : 3), ldsL + EPIX_OFF};
#else
        pg8::EpiHeads<pg8::PolProj> E{PROJ, KMEAN, nullptr, ldsL + EPIX_OFF};
#endif
        pg8::gemm_phase<pg8::EpiHeads<pg8::PolProj>, pg8::StaticOrder, true, PG8_SP2>(ldsL + RING_OFF, g, S, E);
        if (BOTH(1)) GRID_BAR(1);
    }
    if (IN(3)) {
        const float mnl_d_ = att_mnl(A_IN(6), A_IN(7), lane), mnl_m_ = att_mnl(A_IN(4), A_IN(5), lane);
#define get(idx) attn_get((idx), G, vcu, PROJ, MIX, DO, mnl_d_, mnl_m_)
        if (G == 256) {
            {
                float* kmL = (float*)((char*)lds + RING_OFF + att::LDS_KM_OFF);
#pragma unroll
                for (int mi = 0; mi < 2; ++mi) { const int hm = (mi * G + vcu) >> 2; const float* km = KMEAN + (size_t)hm * 8 * 128;
                    kmL[mi * 1024 + tid] = km[tid]; kmL[mi * 1024 + 512 + tid] = km[512 + tid]; }
            }
            att::BlockRef cur = get(0); att::Seam S; att::attn_prime<128, 128, DM, true>(cur, (char*)lds + RING_OFF, S);
            for (int i = 0; i < 12; ++i) { const att::BlockRef nxt = (i + 1 < 12) ? get(i + 1) : cur; att::attn_block<128, 128, DM, true>(cur, nxt, (char*)lds + RING_OFF, S); cur = nxt; }
            VM_WAIT(); __syncthreads();
            float lam;
            { const float a = A_IN(8)[lane] * A_IN(9)[lane] + A_IN(8)[lane + 64] * A_IN(9)[lane + 64];
              const float b = A_IN(10)[lane] * A_IN(11)[lane] + A_IN(10)[lane + 64] * A_IN(11)[lane + 64];
              lam = expf(wave_sum(a)) - expf(wave_sum(b)) + LAM_INIT; }
            const int half = lane >> 5, l5 = lane & 31, gb = vcu >> 5, gdh = (vcu >> 2) & 7, gx = vcu & 3;
            float gv[8];
            { const f32x4 g0 = *(const f32x4*)(A_IN(12) + 8 * l5), g1 = *(const f32x4*)(A_IN(12) + 8 * l5 + 4); gv[0] = g0.x; gv[1] = g0.y; gv[2] = g0.z; gv[3] = g0.w; gv[4] = g1.x; gv[5] = g1.y; gv[6] = g1.z; gv[7] = g1.w; }
            for (int it0 = 0; it0 < 32; it0 += 8) {
                v4u av[8], bv[8];
#pragma unroll
                for (int k = 0; k < 8; ++k) { const int rr = ((it0 + k) * NWAVES + wave) * 2 + half, qb = (rr < 256) ? gx : 7 - gx; const size_t row = (size_t)gb * SEQ + (size_t)qb * 256 + (rr & 255);
                    const bf16* p1 = DO + row * DM + gdh * 512 + 8 * l5; av[k] = *(const v4u*)p1; bv[k] = *(const v4u*)(p1 + 256); }
#pragma unroll
                for (int k = 0; k < 8; ++k) { const int rr = ((it0 + k) * NWAVES + wave) * 2 + half, qb = (rr < 256) ? gx : 7 - gx; const size_t row = (size_t)gb * SEQ + (size_t)qb * 256 + (rr & 255);
                    const unsigned aw[4] = {av[k].x, av[k].y, av[k].z, av[k].w}, bw[4] = {bv[k].x, bv[k].y, bv[k].z, bv[k].w};
                    float o[8]; float ss = 0.f;
#pragma unroll
                    for (int e = 0; e < 4; ++e) { o[2 * e] = __uint_as_float(aw[e] << 16) - lam * __uint_as_float(bw[e] << 16); o[2 * e + 1] = __uint_as_float(aw[e] & 0xffff0000u) - lam * __uint_as_float(bw[e] & 0xffff0000u); }
#pragma unroll
                    for (int e = 0; e < 8; ++e) ss += o[e] * o[e];
                    ss += __shfl_xor(ss, 1); ss += __shfl_xor(ss, 2); ss += __shfl_xor(ss, 4); ss += __shfl_xor(ss, 8); ss += __shfl_xor(ss, 16);
                    const float rs = (1.0f - LAM_INIT) / sqrtf(ss * (1.f / 256.f) + NORM_EPS);
                    v4u w; w.x = pk2(o[0] * rs * gv[0], o[1] * rs * gv[1]); w.y = pk2(o[2] * rs * gv[2], o[3] * rs * gv[3]); w.z = pk2(o[4] * rs * gv[4], o[5] * rs * gv[5]); w.w = pk2(o[6] * rs * gv[6], o[7] * rs * gv[7]);
                    *(v4u*)(MIX + row * DM + 2048 + gdh * 256 + 8 * l5) = w; }
            }
        }
#undef get
        if (BOTH(3)) GRID_BAR(3);
    }
    if (IN(5)) {
        pg8::Gemm g{MIX, W_OUT, M, DM, DM}; pg8::StaticOrder S; S.init(M, DM, G, bx);
        pg8::EpiResNorm<false> E{XIN, XN, PS_CROSS, DM, 64};
        pg8::gemm_phase<pg8::EpiResNorm<false>, pg8::StaticOrder, PG8_ALIGN, PG8_SP2>(ldsL + RING_OFF, g, S, E);
        if (BOTH(5)) GRID_BAR(5);
    }
    if (IN(7)) {
        { pg8::StaticOrder S0; S0.init(M, MW, G, bx); pg8::Unit u0; if (S0.next(0, u0)) rs_panel(PS_CROSS, RS_CROSS, u0.pm, tid); VM_WAIT(); __syncthreads(); }
        { pg8::Gemm g{XN, W_MQ, M, MW, DM}; pg8::StaticOrder S; S.init(M, MW, G, bx);
          { LAS float* gt = (LAS float*)(ldsL + EPIX_OFF + 10240); if (tid < 128) gt[tid] = A_IN(20)[tid]; __syncthreads(); }
          pg8::EpiHeads<pg8::PolQc> E{QC, nullptr, RS_CROSS, ldsL + EPIX_OFF};
          pg8::gemm_phase<pg8::EpiHeads<pg8::PolQc>, pg8::StaticOrder, true, PG8_SP2>(ldsL + RING_OFF, g, S, E); }
        { pg8::Gemm g{MEMN, W_MKV, MM, NKV, DM}; pg8::StaticOrder S; S.init(MM, NKV, G, (bx + G - 128) % G);
          { __syncthreads(); LAS float* gt = (LAS float*)(ldsL + EPIX_OFF + 10240); if (tid < 128) gt[tid] = A_IN(21)[tid]; __syncthreads(); }
          pg8::EpiHeads<pg8::PolKv> E{KVC, nullptr, nullptr, ldsL + EPIX_OFF};
          int t2 = threadIdx.x; asm volatile("" : "+v"(t2));
          pg8::gemm_phase<pg8::EpiHeads<pg8::PolKv>, pg8::StaticOrder, true, PG8_SP2>(ldsL + RING_OFF, g, S, E, t2); }
        if (G == 256 && bx >= 160) {
            LAS float* scr = (LAS float*)(ldsL + RING_OFF + wave * 16384);
            for (int it = CV_P0_A + (bx - 160) * NWAVES + wave; it < CV_S_DN; it += 96 * NWAVES) convert_item(it, ws, scr, lane);
        } else if (G != 256 && bx == 0) { LAS float* scr = (LAS float*)(ldsL + RING_OFF + wave * 16384); for (int it = CV_P0_A + wave; it < CV_S_DN; it += NWAVES) convert_item(it, ws, scr, lane); }
        if (BOTH(7)) GRID_BAR(7);
    }
    if (IN(9)) {
        const float mnl_c_ = att_mnl(A_IN(20), A_IN(21), lane);
        for (int I = vcu; I < BATCH * 4 * 8; I += G) {
            const int b = I >> 5, h = (I >> 3) & 3, qb = I & 7;
            att::BlockRef r; const size_t rq = (size_t)b * SEQ + (size_t)qb * 256, rk = (size_t)b * MEML;
            r.Q = QC + ((size_t)(h * BATCH + b) * SEQ + qb * 256) * 128; r.K = KVC + ((size_t)(h * BATCH + b) * MEML) * 128; r.V = KVC + ((size_t)((4 + h) * BATCH + b) * MEML) * 128; r.O = OC + rq * MW + h * 128; r.moba_qb = -1; r.kmi = 0; r.mnl = mnl_c_;
            r.P0 = 1 << 20; r.skv = MEML;
            att::Seam S; att::attn_prime<128, 128, MW, false>(r, (char*)lds + RING_OFF, S); att::attn_block<128, 128, MW, false>(r, r, (char*)lds + RING_OFF, S);
        }
        if (BOTH(9)) GRID_BAR(9);
    }
    if (IN(10)) {
        pg8::Gemm g{OC, W_MO, M, DM, MW}; pg8::StaticOrder S; S.init(M, DM, G, bx);
        pg8::EpiResNorm<true> E{nullptr, XN, PS_FFN, DM, 64};
        pg8::gemm_phase<pg8::EpiResNorm<true>, pg8::StaticOrder, PG8_ALIGN, PG8_SP2>(ldsL + RING_OFF, g, S, E);
        if (BOTH(10)) GRID_BAR(10);
    }
    if (IN(12)) {
        pg8::Gemm g{XN, W_GU, M, NGU, DM}; pg8::StaticOrder S; S.init(M, NGU, G, bx);
        { pg8::Unit u0; int last = -1; for (int i = 0; S.next(i, u0); ++i) if (u0.pm != last) { rs_panel(PS_FFN, RS_FFN, u0.pm, tid); last = u0.pm; } VM_WAIT(); __syncthreads(); }
        pg8::EpiSwiGLU E{HB, FF, RS_FFN};
        pg8::gemm_phase<pg8::EpiSwiGLU, pg8::StaticOrder, PG8_ALIGN, PG8_SP2, PG8_KSPLIT>(ldsL + RING_OFF, g, S, E);
        if (G == 256 && bx >= 128) {
            LAS float* scr = (LAS float*)(ldsL + RING_OFF + wave * 16384);
            for (int it = CV_S_DN + CV_DN_P0 + (bx - 128) * NWAVES + wave; it < CV_NITEMS; it += 128 * NWAVES) convert_item(it, ws, scr, lane);
        } else if (G != 256 && bx == 0) { LAS float* scr = (LAS float*)(ldsL + RING_OFF + wave * 16384); for (int it = CV_S_DN + CV_DN_P0 + wave; it < CV_NITEMS; it += NWAVES) convert_item(it, ws, scr, lane); }
        if (BOTH(12)) GRID_BAR(12);
    }
    if (IN(13)) {
        pg8::Gemm g{HB, W_DN, M, DM, FF}; pg8::StaticOrder S; S.init(M, DM, G, bx);
        pg8::EpiResOut E{XN, OUTW, DM};
        pg8::gemm_phase<pg8::EpiResOut, pg8::StaticOrder, PG8_ALIGN, PG8_SP2>(ldsL + RING_OFF, g, S, E);
    }
#undef IN
#undef BOTH
#undef XIN
#undef OUTR
#undef OUTW
}

extern "C" void kernel_launch(void* const* d_in, const int* in_sizes, int n_in, void* d_out, int out_size, void* d_ws, size_t ws_size, hipStream_t stream) {
    static int grid = 0;
    if (grid == 0) {
        if (n_in != 26 || in_sizes[0] != M * DM || out_size != M * DM || ws_size < WS_END) { fprintf(stderr, "kernel_launch: shape/workspace mismatch (n_in %d, in0 %d, out %d, ws %zu, need %zu)\n", n_in, n_in > 0 ? in_sizes[0] : -1, out_size, ws_size, (size_t)WS_END); grid = -1; return; }
        int dev = 0, cus = 0, per_cu = 0;
        if (hipGetDevice(&dev) != hipSuccess || hipDeviceGetAttribute(&cus, hipDeviceAttributeMultiprocessorCount, dev) != hipSuccess) { grid = -1; return; }
        if (hipFuncSetAttribute((const void*)mk_fwd, hipFuncAttributeMaxDynamicSharedMemorySize, LDS_BYTES) != hipSuccess) { fprintf(stderr, "kernel_launch: hipFuncSetAttribute failed\n"); grid = -1; return; }
        if (hipOccupancyMaxActiveBlocksPerMultiprocessor(&per_cu, (const void*)mk_fwd, NWAVES * 64, LDS_BYTES) != hipSuccess || per_cu < 1)
            fprintf(stderr, "kernel_launch: note: occupancy query reports %d workgroups per CU\n", per_cu);
        (void)hipGetLastError();
        grid = cus;
    }
    if (grid < 0) return;
    if (hipMemsetAsync((char*)d_ws + WS_CTL, 0, CTL_ZERO_BYTES, stream) != hipSuccess) return;
    Args a{};
    for (int i = 0; i < 26; ++i) a.in[i] = (const float*)d_in[i];
    a.out = (float*)d_out; a.outw = (float*)d_out; a.ws = (unsigned char*)d_ws;
    for (int li = 0; li < N_LAUNCHES; ++li) {
        a.ph_lo = (N_LAUNCHES == NPH) ? li : 0; a.ph_hi = (N_LAUNCHES == NPH) ? li + 1 : NPH; a.li = li; a.pad = 0;
        hipLaunchKernelGGL(mk_fwd, dim3(grid), dim3(NWAVES * 64), LDS_BYTES, stream, a);
        const hipError_t le = hipPeekAtLastError();
        if (le != hipSuccess) { fprintf(stderr, "kernel_launch: launch %d failed: %s\n", li, hipGetErrorName(le)); break; }
    }
#if defined(PROBE_LO)
    a.ph_lo = PROBE_LO; a.ph_hi = PROBE_HI; a.li = 1; a.outw = (float*)((char*)d_ws + WS_W_IN);
    hipLaunchKernelGGL(mk_fwd, dim3(grid), dim3(NWAVES * 64), LDS_BYTES, stream, a);
#endif
}
```

```cpp
#include <hip/hip_runtime.h>
#include <cstdio>
#include <cstdint>
namespace pg8 {
#define PG8_LAS __attribute__((address_space(3)))
typedef unsigned short bf16_t;
typedef short bf16x8 __attribute__((ext_vector_type(8)));
typedef float f32x4 __attribute__((ext_vector_type(4)));
typedef unsigned u32x4 __attribute__((ext_vector_type(4)));
constexpr int BM = 256, BK = 64, HALF = 128, HTB = HALF * BK * 2  , STAGE_BYTES = 8 * HTB, NXCD = 8, WGM = 8;

__host__ __device__ __forceinline__ int lds_byte(int r, int c) { const int st = (r >> 4) * 2 + (c >> 5), rr = r & 15, cc = c & 31, ob = rr * 64 + cc * 2; return st * 1024 + (ob ^ (((ob >> 9) & 1) << 5)); }
__host__ __device__ __forceinline__ void stage_rc(int b, int& R, int& C) { const int st = b / 1024, sb = b % 1024, swz = sb ^ (((sb >> 9) & 1) << 5); R = (st >> 1) * 16 + swz / 64; C = (st & 1) * 32 + (swz % 64) / 2; }
__host__ __device__ __forceinline__ int perm32(int rho) { const int n = rho >> 4, i = rho & 15; return 8 * (i >> 2) + 4 * n + (i & 3); }

struct Unit { int pm, pn; };
struct Gemm { const bf16_t* A; const bf16_t* Bt; int M, N, K; };

struct StaticOrder {
    int nM, nN, nwg, G, c, rot, wgm;
    __host__ __device__ void init(int M, int N, int G_, int c_, int rot_ = 0, int wgm_ = WGM) { nM = M / BM; nN = N / BM; nwg = nM * nN; G = G_; c = c_; rot = rot_; wgm = wgm_; }
    __host__ __device__ __forceinline__ bool next(int i, Unit& u) const {
        const long L = (long)i * G + c; if (L >= nwg) return false;
        int wgid = (int)L; { const int q = nwg / NXCD, r = nwg % NXCD, xcd = wgid % NXCD, off = wgid / NXCD; wgid = (xcd < r ? xcd * (q + 1) : r * (q + 1) + (xcd - r) * q) + off; }
        const int nig = wgm * nN, gid = wgid / nig, fm = gid * wgm, gsz = (nM - fm) < wgm ? (nM - fm) : wgm;
        u.pm = fm + ((wgid % nig) % gsz); u.pn = ((wgid % nig) / gsz + rot * gid) % nN; return true;
    }
    __device__ __forceinline__ void a_ready(const Unit&) const {}
    __device__ __forceinline__ void done(const Unit&) const {}
};

__device__ __forceinline__ unsigned cvt_pk_bf16(float lo, float hi) { unsigned r; asm volatile("v_cvt_pk_bf16_f32 %0, %1, %2" : "=v"(r) : "v"(lo), "v"(hi)); return r; }
typedef float f32x2 __attribute__((ext_vector_type(2)));
typedef int i32x4_t __attribute__((ext_vector_type(4)));
typedef int i32x8_t __attribute__((ext_vector_type(8)));
typedef short bf16x16_t __attribute__((ext_vector_type(16)));
__device__ __forceinline__ f32x2 gelu_pk(f32x2 v) {
    const f32x2 av = __builtin_elementwise_abs(v), d = av * 0.2316418882f + 1.0f;
    f32x2 t; t.x = __builtin_amdgcn_rcpf(d.x); t.y = __builtin_amdgcn_rcpf(d.y);
    f32x2 q = t * 0.5307027145f + (-0.7265760135f); q = q * t + 0.7107068705f; q = q * t + (-0.142248368f); q = q * t + 0.127414796f; q = q * t;
    const f32x2 s = (v * v) * (-0.72134752044f);
    f32x2 e; e.x = __builtin_amdgcn_exp2f(s.x); e.y = __builtin_amdgcn_exp2f(s.y);
    const f32x2 m = v * (q * e), r = v - m;
    f32x2 o; o.x = v.x < 0.f ? m.x : r.x; o.y = v.y < 0.f ? m.y : r.y; return o;
}

template <int ACT  > struct EpiBf16 {
    static constexpr bool PERM = true, AFTER_DRAIN = false, PRELOAD = false; static_assert(ACT == 0 || ACT == 1, "EpiBf16: ACT is 0 (none) or 1 (gelu_pk)");
    bf16_t* O; int ldc; const float* bias; int split_cols; size_t split_stride; float scale0;
    __device__ __forceinline__ void operator()(const f32x4 (&acc)[2][2][4][2], const Unit& u, int wr, int wc, int fr, int fq) const {
        const int row0 = u.pm * BM + wr * 64 + fr; int colt = u.pn * BM; bf16_t* base = O;
        float sc = 1.f; if (split_cols) { const int t = colt / split_cols; base += (size_t)t * split_stride; colt -= t * split_cols; if (t == 0) sc = scale0; }
        const int col0 = colt + wc * 32 + 8 * fq, bcol0 = u.pn * BM + wc * 32 + 8 * fq;
        f32x4 bv[2][2];
#pragma unroll
        for (int bj = 0; bj < 2; ++bj)
#pragma unroll
            for (int n = 0; n < 2; ++n) bv[bj][n] = bias ? *(const f32x4*)(bias + bcol0 + bj * HALF + 4 * n) : (f32x4){0.f, 0.f, 0.f, 0.f};
#pragma unroll
        for (int ai = 0; ai < 2; ++ai)
#pragma unroll
            for (int m = 0; m < 4; ++m) { bf16_t* rowp = base + (size_t)(row0 + ai * HALF + m * 16) * ldc + col0;
#pragma unroll
                for (int bj = 0; bj < 2; ++bj) { f32x4 v0 = acc[ai][bj][m][0] + bv[bj][0], v1 = acc[ai][bj][m][1] + bv[bj][1];
                    if (ACT == 1) { f32x2 a = gelu_pk((f32x2){v0[0], v0[1]}), b = gelu_pk((f32x2){v0[2], v0[3]}), c = gelu_pk((f32x2){v1[0], v1[1]}), d = gelu_pk((f32x2){v1[2], v1[3]});
                        v0 = (f32x4){a.x, a.y, b.x, b.y}; v1 = (f32x4){c.x, c.y, d.x, d.y}; }
                    v0 = v0 * sc; v1 = v1 * sc; u32x4 w; w.x = cvt_pk_bf16(v0[0], v0[1]); w.y = cvt_pk_bf16(v0[2], v0[3]); w.z = cvt_pk_bf16(v1[0], v1[1]); w.w = cvt_pk_bf16(v1[2], v1[3]);
                    *(u32x4*)(rowp + bj * HALF) = w; } }
    }
};


struct EpiResF32 {
    static constexpr bool PERM = false, AFTER_DRAIN = false, PRELOAD = false;
    const float* base; float* out; int ldc;
    __device__ __forceinline__ void operator()(const f32x4 (&acc)[2][2][4][2], const Unit& u, int wr, int wc, int fr, int fq) const {
        const int row0 = u.pm * BM + wr * 64 + fr, col0 = u.pn * BM + wc * 32 + 4 * fq;
#pragma unroll
        for (int ai = 0; ai < 2; ++ai)
#pragma unroll
            for (int m = 0; m < 4; ++m) { const size_t off = (size_t)(row0 + ai * HALF + m * 16) * ldc + col0;
                f32x4 b[2][2];
#pragma unroll
                for (int bj = 0; bj < 2; ++bj)
#pragma unroll
                    for (int n = 0; n < 2; ++n) b[bj][n] = *(const f32x4*)(base + off + bj * HALF + n * 16);
#pragma unroll
                for (int bj = 0; bj < 2; ++bj)
#pragma unroll
                    for (int n = 0; n < 2; ++n) *(f32x4*)(out + off + bj * HALF + n * 16) = b[bj][n] + acc[ai][bj][m][n];
                if (m & 1) asm volatile("" ::: "memory"); }
    }
};
struct EpiSwiGLU {
    static constexpr bool PERM = true, AFTER_DRAIN = false, PRELOAD = true;
    __device__ __forceinline__ void preload(float (&pre)[8], const Unit& u, int wr, int fr) const {
#pragma unroll
        for (int i = 0; i < 8; ++i) { const float* p = RS + u.pm * BM + (i >> 2) * HALF + wr * 64 + (i & 3) * 16 + fr;
            asm volatile("global_load_dword %0, %1, off" : "=&v"(pre[i]) : "v"(p) : "memory"); } }
    bf16_t* H; int ldh; const float* RS;
    __device__ __forceinline__ void operator()(const f32x4 (&acc)[2][2][4][2], const Unit& u, int wr, int wc, int fr, int fq, const float (&pre)[8]) const {
        const int row0 = u.pm * BM + wr * 64 + fr, col0 = u.pn * HALF + wc * 32 + 8 * fq;
#pragma unroll
        for (int ai = 0; ai < 2; ++ai)
#pragma unroll
            for (int m = 0; m < 4; ++m) { const int row = row0 + ai * HALF + m * 16; bf16_t* rowp = H + (size_t)row * ldh + col0;
                const float rs = pre[ai * 4 + m], c1 = rs * -1.4426950408889634f, c2 = rs * rs;
                float h[8];
#pragma unroll
                for (int n = 0; n < 2; ++n)
#pragma unroll
                    for (int e = 0; e < 4; e += 2) { const f32x2 a0 = {acc[ai][0][m][n][e], acc[ai][0][m][n][e + 1]}, a1 = {acc[ai][1][m][n][e], acc[ai][1][m][n][e + 1]};
                        const f32x2 t = a0 * c1; f32x2 d; d.x = __builtin_amdgcn_exp2f(t.x); d.y = __builtin_amdgcn_exp2f(t.y); d = d + 1.0f;
                        f32x2 r; r.x = __builtin_amdgcn_rcpf(d.x); r.y = __builtin_amdgcn_rcpf(d.y);
                        const f32x2 o = ((a0 * a1) * c2) * r; h[n * 4 + e] = o.x; h[n * 4 + e + 1] = o.y; }
                u32x4 w; w.x = cvt_pk_bf16(h[0], h[1]); w.y = cvt_pk_bf16(h[2], h[3]); w.z = cvt_pk_bf16(h[4], h[5]); w.w = cvt_pk_bf16(h[6], h[7]);
                *(u32x4*)rowp = w; }
    }
};

template <bool BASE_BF16> struct EpiResNorm {
    static constexpr bool PERM = true, AFTER_DRAIN = false, PRELOAD = false;
    const float* base; bf16_t* XB; float* PS; int ldc, nps;
    __device__ __forceinline__ void operator()(const f32x4 (&acc)[2][2][4][2], const Unit& u, int wr, int wc, int fr, int fq) const {
        const int row0 = u.pm * BM + wr * 64 + fr, col0 = u.pn * BM + wc * 32 + 8 * fq;
#pragma unroll
        for (int ai = 0; ai < 2; ++ai)
#pragma unroll
            for (int m = 0; m < 4; ++m) { const int row = row0 + ai * HALF + m * 16; const size_t off = (size_t)row * ldc + col0;
                f32x4 b[2][2];
#pragma unroll
                for (int bj = 0; bj < 2; ++bj) {
                    if constexpr (BASE_BF16) { const u32x4 r = *(const u32x4*)(XB + off + bj * HALF);
                        b[bj][0] = (f32x4){__uint_as_float(r.x << 16), __uint_as_float(r.x & 0xffff0000u), __uint_as_float(r.y << 16), __uint_as_float(r.y & 0xffff0000u)};
                        b[bj][1] = (f32x4){__uint_as_float(r.z << 16), __uint_as_float(r.z & 0xffff0000u), __uint_as_float(r.w << 16), __uint_as_float(r.w & 0xffff0000u)}; }
                    else { b[bj][0] = *(const f32x4*)(base + off + bj * HALF); b[bj][1] = *(const f32x4*)(base + off + bj * HALF + 4); } }
                float ss = 0.f;
#pragma unroll
                for (int bj = 0; bj < 2; ++bj) { const f32x4 v0 = b[bj][0] + acc[ai][bj][m][0], v1 = b[bj][1] + acc[ai][bj][m][1];
                    ss += (v0[0] * v0[0] + v0[1] * v0[1]) + (v0[2] * v0[2] + v0[3] * v0[3]) + (v1[0] * v1[0] + v1[1] * v1[1]) + (v1[2] * v1[2] + v1[3] * v1[3]);
                    u32x4 w; w.x = cvt_pk_bf16(v0[0], v0[1]); w.y = cvt_pk_bf16(v0[2], v0[3]); w.z = cvt_pk_bf16(v1[0], v1[1]); w.w = cvt_pk_bf16(v1[2], v1[3]);
                    *(u32x4*)(XB + off + bj * HALF) = w; }
                ss += __shfl_xor(ss, 16); ss += __shfl_xor(ss, 32);
                if (fq == 0) PS[(size_t)row * nps + u.pn * 4 + wc] = ss;
                if (m & 1) asm volatile("" ::: "memory"); }
    }
};
struct EpiResOut {
    static constexpr bool PERM = true, AFTER_DRAIN = false, PRELOAD = false;
    const bf16_t* XB; float* out; int ldc;
    __device__ __forceinline__ void operator()(const f32x4 (&acc)[2][2][4][2], const Unit& u, int wr, int wc, int fr, int fq) const {
        const int row0 = u.pm * BM + wr * 64 + fr, col0 = u.pn * BM + wc * 32 + 8 * fq;
#pragma unroll
        for (int ai = 0; ai < 2; ++ai)
#pragma unroll
            for (int m = 0; m < 4; ++m) { const size_t off = (size_t)(row0 + ai * HALF + m * 16) * ldc + col0;
                u32x4 r[2];
#pragma unroll
                for (int bj = 0; bj < 2; ++bj) r[bj] = *(const u32x4*)(XB + off + bj * HALF);
#pragma unroll
                for (int bj = 0; bj < 2; ++bj) {
                    const f32x4 b0 = {__uint_as_float(r[bj].x << 16), __uint_as_float(r[bj].x & 0xffff0000u), __uint_as_float(r[bj].y << 16), __uint_as_float(r[bj].y & 0xffff0000u)};
                    const f32x4 b1 = {__uint_as_float(r[bj].z << 16), __uint_as_float(r[bj].z & 0xffff0000u), __uint_as_float(r[bj].w << 16), __uint_as_float(r[bj].w & 0xffff0000u)};
                    *(f32x4*)(out + off + bj * HALF) = b0 + acc[ai][bj][m][0]; *(f32x4*)(out + off + bj * HALF + 4) = b1 + acc[ai][bj][m][1]; }
                if (m & 1) asm volatile("" ::: "memory"); }
    }
};
struct EpiBf16RS {
    static constexpr bool PERM = true, AFTER_DRAIN = false, PRELOAD = false;
    bf16_t* O; int ldc; const float* RS;
    __device__ __forceinline__ void operator()(const f32x4 (&acc)[2][2][4][2], const Unit& u, int wr, int wc, int fr, int fq) const {
        const int row0 = u.pm * BM + wr * 64 + fr, col0 = u.pn * BM + wc * 32 + 8 * fq;
#pragma unroll
        for (int ai = 0; ai < 2; ++ai)
#pragma unroll
            for (int m = 0; m < 4; ++m) { const int row = row0 + ai * HALF + m * 16; bf16_t* rowp = O + (size_t)row * ldc + col0;
                const float rs = RS[row];
#pragma unroll
                for (int bj = 0; bj < 2; ++bj) { const f32x4 v0 = acc[ai][bj][m][0] * rs, v1 = acc[ai][bj][m][1] * rs;
                    u32x4 w; w.x = cvt_pk_bf16(v0[0], v0[1]); w.y = cvt_pk_bf16(v0[2], v0[3]); w.z = cvt_pk_bf16(v1[0], v1[1]); w.w = cvt_pk_bf16(v1[2], v1[3]);
                    *(u32x4*)(rowp + bj * HALF) = w; } }
    }
};

template <class Pol> struct EpiHeads {
    static constexpr bool PERM = true, AFTER_DRAIN = false, PRELOAD = false;
    bf16_t* T; float* kmean; const float* RS; PG8_LAS unsigned char* xl;
    __device__ __forceinline__ void operator()(const f32x4 (&acc)[2][2][4][2], const Unit& u, int wr, int wc, int fr, int fq) const {
        const int kind = Pol::kind(u.pn);
        const int b = u.pm / Pol::TPB, s0 = (u.pm % Pol::TPB) * BM;
        PG8_LAS float* P = (PG8_LAS float*)xl;
        PG8_LAS float* KS = (PG8_LAS float*)(xl + 8192);
#define EH_RSC(ai, m) ((Pol::HAS_RS ? RS[u.pm * BM + (ai) * HALF + wr * 64 + (m) * 16 + fr] : 1.f) * Pol::OSC)
        if (kind >= 1) {
#pragma unroll
            for (int ai = 0; ai < 2; ++ai)
#pragma unroll
                for (int m = 0; m < 4; ++m)
#pragma unroll
                    for (int bj = 0; bj < 2; ++bj) { const float rsc_ = EH_RSC(ai, m); const f32x4 a0 = acc[ai][bj][m][0] * rsc_, a1 = acc[ai][bj][m][1] * rsc_;
                        float ss = (a0[0] * a0[0] + a0[1] * a0[1]) + (a0[2] * a0[2] + a0[3] * a0[3]) + (a1[0] * a1[0] + a1[1] * a1[1]) + (a1[2] * a1[2] + a1[3] * a1[3]);
                        ss += __shfl_xor(ss, 16); ss += __shfl_xor(ss, 32);
                        if (fq == 0) P[(bj * BM + ai * HALF + wr * 64 + m * 16 + fr) * 4 + wc] = ss; }
            asm volatile("s_waitcnt lgkmcnt(0)" ::: "memory"); __builtin_amdgcn_s_barrier(); asm volatile("" ::: "memory");
        }
        const PG8_LAS float* g = (const PG8_LAS float*)(xl + 10240) + Pol::gain(u.pn) * 128;
        f32x4 gv0 = {1.f, 1.f, 1.f, 1.f}, gv1 = {1.f, 1.f, 1.f, 1.f};
        if (kind >= 1) { const float qs = Pol::qscale(u.pn); gv0 = *(const PG8_LAS f32x4*)(g + wc * 32 + 8 * fq) * qs; gv1 = *(const PG8_LAS f32x4*)(g + wc * 32 + 8 * fq + 4) * qs; }
        f32x4 cs[2][2];
#pragma unroll
        for (int bj = 0; bj < 2; ++bj) { cs[bj][0] = (f32x4){0.f, 0.f, 0.f, 0.f}; cs[bj][1] = (f32x4){0.f, 0.f, 0.f, 0.f}; }
#pragma unroll
        for (int ai = 0; ai < 2; ++ai)
#pragma unroll
            for (int m = 0; m < 4; ++m) { int r = ai * HALF + wr * 64 + m * 16 + fr; asm volatile("" : "+v"(r));
                f32x4 y[2][2];
#pragma unroll
                for (int bj = 0; bj < 2; ++bj) { float rs = EH_RSC(ai, m);
                    if (kind >= 1) { const f32x4 p = *(const PG8_LAS f32x4*)(P + (bj * BM + r) * 4); rs *= __builtin_amdgcn_rsqf(((p[0] + p[1]) + (p[2] + p[3])) * (1.f / 128.f) + 1e-6f); }
                    y[bj][0] = acc[ai][bj][m][0] * rs * gv0; y[bj][1] = acc[ai][bj][m][1] * rs * gv1; }
                if (kind >= 2 && wc == 0) {
                    constexpr float KTH[8] = {1.000000000e+00f, 4.403666027e-01f, 1.939227447e-01f, 8.539710029e-02f, 3.760603093e-02f, 1.656044008e-02f, 7.292664737e-03f, 3.211445995e-03f};
                    const float arev = (float)(s0 + r) * ((fq & 1) ? 2.250790790e-04f : 0.15915494309f);
                    f32x4 c0, c1, sn0, sn1;
#pragma unroll
                    for (int e = 0; e < 4; ++e) { const float t0 = __builtin_amdgcn_fractf(arev * KTH[e]), t1 = __builtin_amdgcn_fractf(arev * KTH[4 + e]);
                        c0[e] = __builtin_amdgcn_cosf(t0); sn0[e] = __builtin_amdgcn_sinf(t0); c1[e] = __builtin_amdgcn_cosf(t1); sn1[e] = __builtin_amdgcn_sinf(t1); }
                    const float sg = (fq < 2) ? -1.f : 1.f;
#pragma unroll
                    for (int bj = 0; bj < 2; ++bj) { f32x4 p0, p1;
#pragma unroll
                        for (int e = 0; e < 4; ++e) { p0[e] = __shfl_xor(y[bj][0][e], 32); p1[e] = __shfl_xor(y[bj][1][e], 32); }
                        y[bj][0] = y[bj][0] * c0 + p0 * sn0 * sg; y[bj][1] = y[bj][1] * c1 + p1 * sn1 * sg; }
                }
#pragma unroll
                for (int bj = 0; bj < 2; ++bj) {
                    if (kind == 3) { cs[bj][0] += y[bj][0]; cs[bj][1] += y[bj][1]; }
                    u32x4 w; w.x = cvt_pk_bf16(y[bj][0][0], y[bj][0][1]); w.y = cvt_pk_bf16(y[bj][0][2], y[bj][0][3]); w.z = cvt_pk_bf16(y[bj][1][0], y[bj][1][1]); w.w = cvt_pk_bf16(y[bj][1][2], y[bj][1][3]);
                    { int c8 = wc * 32 + 8 * fq; asm volatile("" : "+v"(c8)); *(u32x4*)(T + ((size_t)((2 * u.pn + bj) * Pol::NB + b) * Pol::S + s0 + r) * 128 + c8) = w; } }
                asm volatile("" ::: "memory");
            }
        if (kind == 3) {
#pragma unroll
            for (int bj = 0; bj < 2; ++bj)
#pragma unroll
                for (int n = 0; n < 2; ++n)
#pragma unroll
                    for (int e = 0; e < 4; ++e) { float v = cs[bj][n][e]; v += __shfl_xor(v, 1); v += __shfl_xor(v, 2); v += __shfl_xor(v, 4); v += __shfl_xor(v, 8); cs[bj][n][e] = v; }
            if (fr == 0) {
#pragma unroll
                for (int bj = 0; bj < 2; ++bj) { *(PG8_LAS f32x4*)(KS + wr * 256 + bj * HALF + wc * 32 + 8 * fq) = cs[bj][0]; *(PG8_LAS f32x4*)(KS + wr * 256 + bj * HALF + wc * 32 + 8 * fq + 4) = cs[bj][1]; } }
            asm volatile("s_waitcnt lgkmcnt(0)" ::: "memory"); __builtin_amdgcn_s_barrier(); asm volatile("" ::: "memory");
            int t = threadIdx.x; asm volatile("" : "+v"(t));
            if (t < 256) { const int h = Pol::kmhead(u.pn) + (t >> 7);
                kmean[((size_t)(b * 16 + h) * 8 + (u.pm % Pol::TPB)) * 128 + (t & 127)] = (KS[t] + KS[256 + t]) * (1.f / 256.f); }
        }
    }
};
#undef EH_RSC
struct PolProj {
    static constexpr int TPB = 8, NB = 8, S = 2048; static constexpr bool HAS_RS = false; static constexpr float OSC = 1.f;
    __device__ static __forceinline__ int kind(int pn) { return pn < 8 ? 2 : pn < 16 ? 3 : pn < 24 ? 0 : pn < 40 ? 2 : 0; }
    __device__ static __forceinline__ int gain(int pn) { return pn < 8 ? 0 : pn < 16 ? 1 : pn < 32 ? 2 : 3; }
    __device__ static __forceinline__ int kmhead(int pn) { return 2 * (pn - 8); }
    __device__ static __forceinline__ float qscale(int pn) { return (pn < 8 || (pn >= 24 && pn < 32)) ? 0.12751743074602325f : 1.f; }
};
struct PolProj8 {
    static constexpr int TPB = 8, NB = 8, S = 2048; static constexpr bool HAS_RS = false; static constexpr float OSC = 1.f / 256.f;
    __device__ static __forceinline__ int kind(int pn) { return pn < 8 ? 2 : pn < 16 ? 3 : pn < 24 ? 0 : pn < 40 ? 2 : 0; }
    __device__ static __forceinline__ int gain(int pn) { return pn < 8 ? 0 : pn < 16 ? 1 : pn < 32 ? 2 : 3; }
    __device__ static __forceinline__ int kmhead(int pn) { return 2 * (pn - 8); }
    __device__ static __forceinline__ float qscale(int pn) { return (pn < 8 || (pn >= 24 && pn < 32)) ? 0.12751743074602325f : 1.f; }
};
struct OrderSkip : StaticOrder {
    int lo, add;
    __device__ __forceinline__ bool next(int i, Unit& u) const { if (!StaticOrder::next(i, u)) return false; if (u.pn >= lo) u.pn += add; return true; }
};
struct PolQc {
    static constexpr int TPB = 8, NB = 8, S = 2048; static constexpr bool HAS_RS = true; static constexpr float OSC = 1.f;
    __device__ static __forceinline__ float qscale(int) { return 0.12751743074602325f; }
    __device__ static __forceinline__ int kind(int) { return 1; }
    __device__ static __forceinline__ int gain(int) { return 0; }
    __device__ static __forceinline__ int kmhead(int) { return 0; }
};
struct PolKv {
    static constexpr int TPB = 1, NB = 8, S = 256; static constexpr bool HAS_RS = false; static constexpr float OSC = 1.f;
    __device__ static __forceinline__ float qscale(int) { return 1.f; }
    __device__ static __forceinline__ int kind(int pn) { return pn < 2 ? 1 : 0; }
    __device__ static __forceinline__ int gain(int) { return 0; }
    __device__ static __forceinline__ int kmhead(int) { return 0; }
};

template <class Epi, class Sched, bool ALIGN_EPI = false, bool SP2 = false, bool KSPLIT = false, bool FP8 = false>
__device__ __forceinline__ void gemm_phase(PG8_LAS unsigned char* lds, const Gemm g, const Sched& S, const Epi& E, const int tid_in = -1) {
    const int tid = tid_in < 0 ? (int)threadIdx.x : tid_in, wid = __builtin_amdgcn_readfirstlane(tid >> 6), lane = tid & 63, wr = wid >> 2, wc = wid & 3, fr = lane & 15, fq = lane >> 4;
    static_assert(!(FP8 && KSPLIT), "FP8 uses the plain loop");
    const int K = g.K, nt = K / BK;
    unsigned voffA[2], voffB[2];
#pragma unroll
    for (int i = 0; i < 2; ++i) { int R, C; stage_rc(tid * 16 + i * 8192, R, C); const int Rb = Epi::PERM ? ((R & ~31) + perm32(R & 31)) : R;
        voffA[i] = (unsigned)(R * K + C) * 2u; voffB[i] = (unsigned)(Rb * K + C) * 2u; }
    unsigned vA2[2], vB2[2];
#pragma unroll
    for (int h = 0; h < 2; ++h) { int R, C; stage_rc((2 * wid + h) * 1024 + lane * 16, R, C); const int Rb = Epi::PERM ? ((R & ~31) + perm32(R & 31)) : R;
        vA2[h] = (unsigned)(R * K + C) * 2u; vB2[h] = (unsigned)(Rb * K + C) * 2u; }
    const size_t kstep = (size_t)(BK * 2);
    const size_t hstep = (size_t)HALF * K * 2;
    const size_t tstep = 2 * hstep;
    const unsigned ldsw = (unsigned)wid * 1024u;
    const int aoff = lds_byte(wr * 64 + fr, fq * 8), boff = lds_byte(wc * 32 + fr, fq * 8);
#define PG8_SA(b, h) (((b) * 2 + (h)) * HTB)
#define PG8_SB(b, h) ((4 + (b) * 2 + (h)) * HTB)
#define PG8_STAGE(bufoff, gbase, voff) do { _Pragma("unroll") for (int _i = 0; _i < 2; ++_i) \
        __builtin_amdgcn_global_load_lds((const unsigned*)((const char*)(gbase) + (voff)[_i]), (PG8_LAS unsigned*)(lds + (bufoff) + ldsw + _i * 8192), 16, 0, 0); } while (0)
#define PG8_LDA(dst, b, h) do { _Pragma("unroll") for (int m = 0; m < 4; ++m) { if constexpr (FP8) { dst##8[m].lo = *(const PG8_LAS bf16x8*)(lds + PG8_SA(b, h) + aoff + m * 2048); dst##8[m].hi = *(const PG8_LAS bf16x8*)(lds + PG8_SA(b, h) + aoff + m * 2048 + 1024); } \
        else { _Pragma("unroll") for (int k = 0; k < 2; ++k) dst[m][k] = *(const PG8_LAS bf16x8*)(lds + PG8_SA(b, h) + aoff + m * 2048 + k * 1024); } } } while (0)
#define PG8_LDB(dst, b, h) do { _Pragma("unroll") for (int n = 0; n < 2; ++n) { if constexpr (FP8) { dst##8[n].lo = *(const PG8_LAS bf16x8*)(lds + PG8_SB(b, h) + boff + n * 2048); dst##8[n].hi = *(const PG8_LAS bf16x8*)(lds + PG8_SB(b, h) + boff + n * 2048 + 1024); } \
        else { _Pragma("unroll") for (int k = 0; k < 2; ++k) dst[n][k] = *(const PG8_LAS bf16x8*)(lds + PG8_SB(b, h) + boff + n * 2048 + k * 1024); } } } while (0)
#define PG8_F8CAT(x0, x1) __builtin_shufflevector(__builtin_bit_cast(i32x4_t, x0), __builtin_bit_cast(i32x4_t, x1), 0, 1, 2, 3, 4, 5, 6, 7)
#define PG8_MMA(ai, bj, At, Bt) do { __builtin_amdgcn_s_setprio(1); _Pragma("unroll") for (int m = 0; m < 4; ++m) _Pragma("unroll") for (int n = 0; n < 2; ++n) { \
        if constexpr (FP8) { const i32x8_t b8_ = __builtin_bit_cast(i32x8_t, Bt##8[n]), a8_ = __builtin_bit_cast(i32x8_t, At##8[m]);     \
            asm volatile("v_mfma_f32_16x16x128_f8f6f4 %0, %1, %2, %0" : "+v"(acc[ai][bj][m][n]) : "v"(b8_), "v"(a8_)); } \
        else { _Pragma("unroll") for (int k = 0; k < 2; ++k) acc[ai][bj][m][n] = __builtin_amdgcn_mfma_f32_16x16x32_bf16(Bt[n][k], At[m][k], acc[ai][bj][m][n], 0, 0, 0); } } __builtin_amdgcn_s_setprio(0); } while (0)
#define PG8_STG1(bufoff, gbase, voffh, h) __builtin_amdgcn_global_load_lds((const unsigned*)((const char*)(gbase) + (voffh)), (PG8_LAS unsigned*)(lds + (bufoff) + (2 * wid + (h)) * 1024), 16, 0, 0)
#define PG8_STAGE_K(b, h, ap, bp) do { PG8_STG1(PG8_SA(b, 0), ap, vA2[h], h); PG8_STG1(PG8_SA(b, 1), (ap) + hstep, vA2[h], h); PG8_STG1(PG8_SB(b, 0), bp, vB2[h], h); PG8_STG1(PG8_SB(b, 1), (bp) + hstep, vB2[h], h); } while (0)
#define PG8_LDK(b, k) do { _Pragma("unroll") for (int ai = 0; ai < 2; ++ai) _Pragma("unroll") for (int m = 0; m < 4; ++m) Af[ai][m] = *(const PG8_LAS bf16x8*)(lds + PG8_SA(b, ai) + aoff + m * 2048 + (k) * 1024); \
        _Pragma("unroll") for (int bj = 0; bj < 2; ++bj) _Pragma("unroll") for (int n = 0; n < 2; ++n) Bf[bj][n] = *(const PG8_LAS bf16x8*)(lds + PG8_SB(b, bj) + boff + n * 2048 + (k) * 1024); } while (0)
#define PG8_MMK() do { __builtin_amdgcn_s_setprio(1); _Pragma("unroll") for (int ai = 0; ai < 2; ++ai) _Pragma("unroll") for (int bj = 0; bj < 2; ++bj) _Pragma("unroll") for (int m = 0; m < 4; ++m) _Pragma("unroll") for (int n = 0; n < 2; ++n) \
        acc[ai][bj][m][n] = __builtin_amdgcn_mfma_f32_16x16x32_bf16(Bf[bj][n], Af[ai][m], acc[ai][bj][m][n], 0, 0, 0); __builtin_amdgcn_s_setprio(0); } while (0)
#define PG8_WAIT_V(n) asm volatile("s_waitcnt vmcnt(" #n ")" ::: "memory")
#define PG8_WAIT_L(n) asm volatile("s_waitcnt lgkmcnt(" #n ")" ::: "memory")
#define PG8_BAR __builtin_amdgcn_s_barrier()
#define PG8_SCHED __builtin_amdgcn_sched_barrier(0)
    Unit cur, nxt; int ui = 0;
    if (!S.next(0, cur)) return;
    f32x4 acc[2][2][4][2];
#pragma unroll
    for (int a = 0; a < 2; ++a)
#pragma unroll
        for (int b = 0; b < 2; ++b)
#pragma unroll
            for (int m = 0; m < 4; ++m)
#pragma unroll
                for (int n = 0; n < 2; ++n) acc[a][b][m][n] = (f32x4){0.f, 0.f, 0.f, 0.f};
    bf16x8 At[4][2], B0[2][2], B1[2][2];
    bf16x16_t At8[4], B08[2], B18[2];
    bf16x8 Af[2][4], Bf[2][2];
    const char* cA = (const char*)g.A + (size_t)cur.pm * tstep; const char* cB = (const char*)g.Bt + (size_t)cur.pn * tstep;
    S.a_ready(cur);
    float pre[8]; if constexpr (Epi::PRELOAD) E.preload(pre, cur, wr, fr);
    if constexpr (KSPLIT) {
        PG8_STAGE_K(0, 0, cA, cB); PG8_STAGE_K(0, 1, cA, cB); PG8_STAGE_K(1, 0, cA + kstep, cB + kstep);
        if (wr == 1) PG8_BAR;
        PG8_WAIT_V(8); PG8_BAR;
        PG8_BAR;
    } else
    if constexpr (SP2) {
        PG8_STAGE(PG8_SB(0, 0), cB, voffB); PG8_STAGE(PG8_SB(0, 1), cB + hstep, voffB); PG8_STAGE(PG8_SA(0, 0), cA, voffA); PG8_STAGE(PG8_SA(0, 1), cA + hstep, voffA);
        if (wr == 1) PG8_BAR;
        PG8_WAIT_V(2); PG8_BAR;
        PG8_STAGE(PG8_SB(1, 0), cB + kstep, voffB); PG8_STAGE(PG8_SA(1, 0), cA + kstep, voffA); PG8_STAGE(PG8_SB(1, 1), cB + hstep + kstep, voffB);
        PG8_WAIT_V(6); PG8_BAR;
    } else {
        PG8_STAGE(PG8_SB(0, 0), cB, voffB); PG8_STAGE(PG8_SA(0, 0), cA, voffA); PG8_STAGE(PG8_SB(0, 1), cB + hstep, voffB); PG8_STAGE(PG8_SA(0, 1), cA + hstep, voffA);
        if (wr == 1) PG8_BAR;
        PG8_WAIT_V(4); PG8_BAR;
        PG8_STAGE(PG8_SB(1, 0), cB + kstep, voffB); PG8_STAGE(PG8_SA(1, 0), cA + kstep, voffA); PG8_STAGE(PG8_SB(1, 1), cB + hstep + kstep, voffB);
        PG8_WAIT_V(6); PG8_BAR;
    }
    for (;;) {
        const bool has_next = S.next(ui + 1, nxt);
        const char* nA = has_next ? (const char*)g.A + (size_t)nxt.pm * tstep : cA; const char* nB = has_next ? (const char*)g.Bt + (size_t)nxt.pn * tstep : cB;
        for (int t = 0; t < nt; t += 2) {
            const bool last = (t == nt - 2);
            const char* a1 = cA + (size_t)(t + 1) * kstep;
            const char* a2 = last ? nA : cA + (size_t)(t + 2) * kstep; const char* b2 = last ? nB : cB + (size_t)(t + 2) * kstep;
            const char* a3 = a2 + kstep; const char* b3 = b2 + kstep;
            if (last && has_next) S.a_ready(nxt);
            if constexpr (KSPLIT) {
            const char* b1 = cB + (size_t)(t + 1) * kstep;
            PG8_LDK(0, 0); PG8_STAGE_K(1, 1, a1, b1); PG8_WAIT_V(8); PG8_WAIT_L(0); PG8_BAR; PG8_MMK(); PG8_BAR; PG8_SCHED;
            PG8_LDK(0, 1); PG8_STAGE_K(0, 0, a2, b2); PG8_WAIT_V(8); PG8_WAIT_L(0); PG8_BAR; PG8_MMK(); PG8_BAR; PG8_SCHED;
            PG8_LDK(1, 0); PG8_STAGE_K(0, 1, a2, b2); PG8_WAIT_V(8); PG8_WAIT_L(0); PG8_BAR; PG8_MMK(); PG8_BAR; PG8_SCHED;
            PG8_LDK(1, 1); PG8_STAGE_K(1, 0, a3, b3); PG8_WAIT_V(8); PG8_WAIT_L(0); PG8_BAR; PG8_MMK(); PG8_BAR; PG8_SCHED;
            } else
            if constexpr (SP2) {
            PG8_LDB(B0, 0, 0); PG8_LDB(B1, 0, 1); PG8_SCHED; PG8_LDA(At, 0, 0); PG8_STAGE(PG8_SA(1, 1), a1 + hstep, voffA);
            PG8_WAIT_V(8); PG8_WAIT_L(0); PG8_BAR; PG8_MMA(0, 0, At, B0); PG8_MMA(0, 1, At, B1); PG8_BAR; PG8_SCHED;
            PG8_LDA(At, 0, 1); PG8_STAGE(PG8_SB(0, 0), b2, voffB); PG8_STAGE(PG8_SB(0, 1), b2 + hstep, voffB); PG8_STAGE(PG8_SA(0, 0), a2, voffA);
            PG8_WAIT_V(8); PG8_WAIT_L(0); PG8_BAR; PG8_MMA(1, 0, At, B0); PG8_MMA(1, 1, At, B1); PG8_BAR; PG8_SCHED;
            PG8_LDB(B0, 1, 0); PG8_LDB(B1, 1, 1); PG8_SCHED; PG8_LDA(At, 1, 0); PG8_STAGE(PG8_SA(0, 1), a2 + hstep, voffA);
            PG8_WAIT_V(8); PG8_WAIT_L(0); PG8_BAR; PG8_MMA(0, 0, At, B0); PG8_MMA(0, 1, At, B1); PG8_BAR; PG8_SCHED;
            PG8_LDA(At, 1, 1); PG8_STAGE(PG8_SB(1, 0), b3, voffB); PG8_STAGE(PG8_SB(1, 1), b3 + hstep, voffB); PG8_STAGE(PG8_SA(1, 0), a3, voffA);
            PG8_WAIT_V(8); PG8_WAIT_L(0); PG8_BAR; PG8_MMA(1, 0, At, B0); PG8_MMA(1, 1, At, B1); PG8_BAR; PG8_SCHED;
            } else {
            PG8_LDB(B0, 0, 0); PG8_SCHED; PG8_LDA(At, 0, 0); PG8_STAGE(PG8_SA(1, 1), a1 + hstep, voffA);
            PG8_WAIT_L(8); PG8_BAR; PG8_WAIT_L(0); PG8_MMA(0, 0, At, B0); PG8_BAR; PG8_SCHED;
            PG8_LDB(B1, 0, 1); PG8_STAGE(PG8_SB(0, 0), b2, voffB);
            PG8_BAR; PG8_WAIT_L(0); PG8_MMA(0, 1, At, B1); PG8_BAR;
            PG8_LDA(At, 0, 1); PG8_STAGE(PG8_SA(0, 0), a2, voffA);
            PG8_BAR; PG8_WAIT_L(0); PG8_MMA(1, 0, At, B0); PG8_BAR; PG8_SCHED;
            PG8_STAGE(PG8_SB(0, 1), b2 + hstep, voffB);
            PG8_WAIT_V(6); PG8_BAR; PG8_MMA(1, 1, At, B1); PG8_BAR;
            PG8_LDB(B0, 1, 0); PG8_SCHED; PG8_LDA(At, 1, 0); PG8_STAGE(PG8_SA(0, 1), a2 + hstep, voffA);
            PG8_WAIT_L(8); PG8_BAR; PG8_WAIT_L(0); PG8_MMA(0, 0, At, B0); PG8_BAR; PG8_SCHED;
            PG8_LDB(B1, 1, 1); PG8_STAGE(PG8_SB(1, 0), b3, voffB);
            PG8_BAR; PG8_WAIT_L(0); PG8_MMA(0, 1, At, B1); PG8_BAR;
            PG8_LDA(At, 1, 1); PG8_STAGE(PG8_SA(1, 0), a3, voffA);
            PG8_BAR; PG8_WAIT_L(0); PG8_MMA(1, 0, At, B0); PG8_BAR; PG8_SCHED;
            PG8_STAGE(PG8_SB(1, 1), b3 + hstep, voffB);
            PG8_WAIT_V(6); PG8_BAR; PG8_MMA(1, 1, At, B1); PG8_BAR;
            }
        }
        if constexpr (ALIGN_EPI) { if (wr == 0) PG8_BAR; }
        if constexpr (FP8) asm volatile("s_nop 15\n\ts_nop 15" ::: "memory");
        if constexpr (!Epi::AFTER_DRAIN) { if constexpr (Epi::PRELOAD) E(acc, cur, wr, wc, fr, fq, pre); else E(acc, cur, wr, wc, fr, fq); S.done(cur); }
        if (!has_next) break;
#pragma unroll
        for (int a = 0; a < 2; ++a)
#pragma unroll
            for (int b = 0; b < 2; ++b)
#pragma unroll
                for (int m = 0; m < 4; ++m)
#pragma unroll
                    for (int n = 0; n < 2; ++n) acc[a][b][m][n] = (f32x4){0.f, 0.f, 0.f, 0.f};
        cur = nxt; cA = nA; cB = nB; ++ui;
        if constexpr (Epi::PRELOAD) E.preload(pre, cur, wr, fr);
        if constexpr (ALIGN_EPI) { if (wr == 1) PG8_BAR; }
    }
    PG8_WAIT_V(0);
    if constexpr (!ALIGN_EPI) { if (wr == 0) PG8_BAR; }
    PG8_BAR;
    if constexpr (Epi::AFTER_DRAIN) { E.fused(acc, cur, wr, wc, fr, fq, lds, wid, lane); S.done(cur); }
#undef PG8_SA
#undef PG8_SB
#undef PG8_STAGE
#undef PG8_LDA
#undef PG8_LDB
#undef PG8_MMA
#undef PG8_STG1
#undef PG8_STAGE_K
#undef PG8_LDK
#undef PG8_MMK
#undef PG8_WAIT_V
#undef PG8_WAIT_L
#undef PG8_BAR
#undef PG8_SCHED
}
}

#ifndef PG8_KSPLIT
#define PG8_KSPLIT false
#endif
#ifndef PG8_SP2
#define PG8_SP2 true
#endif
#ifndef PG8_ALIGN
#define PG8_ALIGN true
#endif


namespace att {
typedef unsigned short bf16;
typedef short bf16x8 __attribute__((ext_vector_type(8)));
typedef short s16x4 __attribute__((ext_vector_type(4)));
typedef float f32x16 __attribute__((ext_vector_type(16)));
typedef float f32x4 __attribute__((ext_vector_type(4)));
typedef unsigned u32x4 __attribute__((ext_vector_type(4)));
constexpr int NW = 8, QBLK = 32, KVBLK = 64, QB = NW * QBLK, D = 128;
constexpr float SCALE = 0.08838834764831845f;
constexpr float THR = 8.f;
constexpr int SHM_V = KVBLK * D * 2, SHM_K = KVBLK * D * 2;
constexpr int NVB = 3;
constexpr int LDS_WS_OFF = NVB * SHM_V + 2 * SHM_K, LDS_KM_OFF = LDS_WS_OFF + NW * 64 * 4, LDS_BYTES = LDS_KM_OFF + 2 * 4096;
constexpr unsigned WBIG = 0x40000000u;

#define KSWZ(row, colB) ((row) * 256 + ((colB) ^ (((row) & 7) << 4)))
#define SBAR() __builtin_amdgcn_sched_barrier(0)
__device__ __forceinline__ int v_st(int k, int c) { const int kk = (k & ~0xC) | ((k & 4) << 1) | ((k & 8) >> 1); return ((kk >> 3) * 4 + (c >> 5)) * 512 + ((kk & 7) * 32 + (c & 31)) * 2; }
__device__ __forceinline__ int v_rd_base(int lane) { return ((lane & 3) << 3) | (((lane >> 2) & 3) << 6) | (((lane >> 4) & 1) << 5) | (((lane >> 5) & 1) << 8); }
constexpr int v_rd_off(int d0, int ks, int half) { return d0 * 512 + ks * 4096 + half * 2048; }
__device__ __forceinline__ int crow(int r, int hi) { return (r & 3) + 8 * (r >> 2) + 4 * hi; }
__device__ __forceinline__ unsigned cvtpk(float lo, float hi) { unsigned r; asm volatile("v_cvt_pk_bf16_f32 %0, %1, %2" : "=v"(r) : "v"(lo), "v"(hi)); return r; }
__device__ __forceinline__ bf16x8 load8(const bf16* p) { return *reinterpret_cast<const bf16x8*>(p); }
__device__ __forceinline__ void mask_tile(f32x16& p0, f32x16& p1, int dq, unsigned W) {
    const float NEG = -__builtin_inff();
#pragma unroll
    for (int r = 0; r < 16; ++r) {
        const int c = (r & 3) + 8 * (r >> 2);
        if ((unsigned)(dq - c) >= W) p0[r] = NEG;
        if ((unsigned)(dq - c - 32) >= W) p1[r] = NEG;
    }
}
__device__ __forceinline__ void mask_tile_post(f32x16& p0, f32x16& p1, int dq, unsigned W) {
    const float NEG = -__builtin_inff();
#pragma unroll
    for (int r = 0; r < 16; ++r) {
        const int c = (r & 3) + 8 * (r >> 2);
        if ((unsigned)(dq - c) >= W) p0[r] = 0.f;
        if ((unsigned)(dq - c - 32) >= W) p1[r] = NEG;
    }
}
__device__ __forceinline__ void partialSM(f32x16& p0, f32x16& p1, float& m_reg, float& mn, float& alpha) {
    float pmax = p0[0]; for (int r = 1; r < 16; ++r) pmax = fmaxf(pmax, p0[r]); for (int r = 0; r < 16; ++r) pmax = fmaxf(pmax, p1[r]);
    { auto rr = __builtin_amdgcn_permlane32_swap(__float_as_uint(pmax), __float_as_uint(pmax), false, false);
      pmax = fmaxf(__uint_as_float(rr[0]), __uint_as_float(rr[1])); }
    constexpr float C2 = 1.4426950408889634f * SCALE;
    if (__builtin_expect(__all((pmax - m_reg) * SCALE <= THR), 1)) { mn = m_reg; alpha = 1.f; }
    else { mn = fmaxf(m_reg, pmax); alpha = __builtin_amdgcn_exp2f((m_reg - mn) * C2); m_reg = mn; }
    const float mnL = -mn * C2;
    for (int r = 0; r < 16; ++r) p0[r] = fmaf(p0[r], C2, mnL); for (int r = 0; r < 16; ++r) p1[r] = fmaf(p1[r], C2, mnL);
    for (int r = 0; r < 16; ++r) p0[r] = __builtin_amdgcn_exp2f(p0[r]);
}
#ifndef ATT_FIXEDMAX
#define ATT_FIXEDMAX 1
#endif
__device__ __forceinline__ void partialSM_fixed(f32x16& p0, f32x16& p1) {
    for (int r = 0; r < 16; ++r) p0[r] = __builtin_amdgcn_exp2f(p0[r]);
}
__device__ __forceinline__ void finishSM(f32x16& p0, f32x16& p1, float alpha, float& l_reg, bf16x8& pa0, bf16x8& pa1, bf16x8& pa2, bf16x8& pa3) {
    for (int r = 0; r < 16; ++r) p1[r] = __builtin_amdgcn_exp2f(p1[r]);
    float ps = 0; for (int r = 0; r < 16; ++r) ps += p0[r]; for (int r = 0; r < 16; ++r) ps += p1[r];
    { auto rr = __builtin_amdgcn_permlane32_swap(__float_as_uint(ps), __float_as_uint(ps), false, false);
      ps = __uint_as_float(rr[0]) + __uint_as_float(rr[1]); }
    l_reg = l_reg * alpha + ps;
#define PK4(P, B_, OUT) do { unsigned a0 = cvtpk(P[B_+0], P[B_+1]), a1 = cvtpk(P[B_+2], P[B_+3]);                          \
        unsigned b0 = cvtpk(P[B_+4], P[B_+5]), b1 = cvtpk(P[B_+6], P[B_+7]);                                             \
        auto r0 = __builtin_amdgcn_permlane32_swap(a0, b0, false, false); auto r1 = __builtin_amdgcn_permlane32_swap(a1, b1, false, false); \
        u32x4 w = {r0[0], r1[0], r0[1], r1[1]}; OUT = *reinterpret_cast<bf16x8*>(&w); } while (0)
    PK4(p0, 0, pa0); PK4(p0, 8, pa1); PK4(p1, 0, pa2); PK4(p1, 8, pa3);
#undef PK4
}
template <int KB>
__device__ __forceinline__ void qkt(f32x16& p0, f32x16& p1, const char* K_lds, int r32, int hi, const bf16x8* qr, float cinit) {
#pragma unroll
    for (int r = 0; r < 16; ++r) { p0[r] = cinit; p1[r] = cinit; }
    const char* kb[4];
#pragma unroll
    for (int dd = 0; dd < 4; ++dd) kb[dd] = K_lds + KB * SHM_K + KSWZ(r32, (dd * 16 + hi * 8) * 2);
#pragma unroll
    for (int d0 = 0; d0 < 8; ++d0) { const char* a = kb[d0 & 3] + (d0 >> 2) * 128;
        bf16x8 b0 = *reinterpret_cast<const bf16x8*>(a);
        bf16x8 b1 = *reinterpret_cast<const bf16x8*>(a + 32 * 256);
        p0 = __builtin_amdgcn_mfma_f32_32x32x16_bf16(b0, qr[d0], p0, 0, 0, 0);
        p1 = __builtin_amdgcn_mfma_f32_32x32x16_bf16(b1, qr[d0], p1, 0, 0, 0); }
}
typedef short v4i16_t __attribute__((ext_vector_type(4)));
typedef __attribute__((address_space(3))) v4i16_t* lds_v4i16_ptr;
template <bool EXPS>
__device__ __forceinline__ void pv_tile(f32x16* o, int vb0, bf16x8 pa0, bf16x8 pa1, bf16x8 pa2, bf16x8 pa3, f32x16& px) {
    const __attribute__((address_space(3))) char* vp = (const __attribute__((address_space(3))) char*)(unsigned)vb0;
#define TRRD(off) __builtin_bit_cast(s16x4, __builtin_amdgcn_ds_read_tr16_b64_v4i16((lds_v4i16_ptr)(vp + (off))))
#define PV_RD(i, L, H) do { constexpr int o_ = v_rd_off((i) & 3, (i) >> 2, 0); L = TRRD(o_); H = TRRD(o_ + 2048); } while (0)
#define PV_PA(ks) ((ks) == 0 ? pa0 : (ks) == 1 ? pa1 : (ks) == 2 ? pa2 : pa3)
#define PV_STEP(i, L, H) do { o[(i) & 3] = __builtin_amdgcn_mfma_f32_32x32x16_bf16((bf16x8){L[0], L[1], L[2], L[3], H[0], H[1], H[2], H[3]}, PV_PA((i) >> 2), o[(i) & 3], 0, 0, 0);     \
        if ((i) + 4 < 16) PV_RD((i) + 4, L, H); if constexpr (EXPS) px[i] = __builtin_amdgcn_exp2f(px[i]); SBAR(); } while (0)
    s16x4 l0, h0, l1, h1, l2, h2, l3, h3;
    PV_RD(0, l0, h0); PV_RD(1, l1, h1); PV_RD(2, l2, h2); PV_RD(3, l3, h3); SBAR();
    PV_STEP(0, l0, h0); PV_STEP(1, l1, h1); PV_STEP(2, l2, h2); PV_STEP(3, l3, h3);
    PV_STEP(4, l0, h0); PV_STEP(5, l1, h1); PV_STEP(6, l2, h2); PV_STEP(7, l3, h3);
    PV_STEP(8, l0, h0); PV_STEP(9, l1, h1); PV_STEP(10, l2, h2); PV_STEP(11, l3, h3);
    PV_STEP(12, l0, h0); PV_STEP(13, l1, h1); PV_STEP(14, l2, h2); PV_STEP(15, l3, h3);
#undef PV_STEP
#undef PV_PA
#undef PV_RD
#undef TRRD
}

struct BlockRef { const bf16* Q; const bf16* K; const bf16* V; bf16* O; int P0, skv, moba_qb, kmi; float mnl; };
struct Seam { bf16x8 qr[8]; bf16x8 st_v0, st_v1, st_k0, st_k1; };
#define ROWP(p, k0, rr) ((p) + (size_t)((k0) + (rr)) * PKV + sc)
#define VMW() asm volatile("s_waitcnt vmcnt(0)" ::: "memory")
#define VMWN(n) asm volatile("s_waitcnt vmcnt(%0)" :: "i"(n) : "memory")
#define SLOAD_H(Kp, Vp, k0) do { S.st_v0 = load8(ROWP(Vp, k0, sr)); S.st_v1 = load8(ROWP(Vp, k0, 32 + sr));              \
                                 S.st_k0 = load8(ROWP(Kp, k0, sr)); S.st_k1 = load8(ROWP(Kp, k0, 32 + sr)); } while (0)
#define SWRITE_HK(bf) do { *(bf16x8*)(K_lds + (bf) * SHM_K + kws) = S.st_k0; *(bf16x8*)(K_lds + (bf) * SHM_K + kws + 32 * 256) = S.st_k1; } while (0)
#define SWRITE_HV(voff) do { *(bf16x8*)(V_lds + (voff) + vst0) = S.st_v0; *(bf16x8*)(V_lds + (voff) + vst1) = S.st_v1; } while (0)
#define SWRITE_H(kb, voff) do { SWRITE_HV(voff); SWRITE_HK(kb); } while (0)
template <int PQ, int PKV, int PO, bool MOBA>
__device__ __forceinline__ void attn_prime(const BlockRef& cur, char* lds, Seam& S) {
    const int tid = threadIdx.x, wid = __builtin_amdgcn_readfirstlane(tid >> 6), lane = tid & 63, r32 = lane & 31, hi = lane >> 5;
    const int sr = tid >> 4, sc = (tid & 15) * 8, kws = KSWZ(sr, sc * 2); char* K_lds = lds + NVB * SHM_V;
    for (int d0 = 0; d0 < 8; ++d0) S.qr[d0] = load8(cur.Q + (size_t)(wid * QBLK + r32) * PQ + d0 * 16 + hi * 8);
    SLOAD_H(cur.K, cur.V, 0);
    VMW(); SWRITE_HK(0);
    __syncthreads();
}
template <int PQ, int PKV, int PO, bool MOBA>
__device__ __forceinline__ void attn_block(const BlockRef& cur, const BlockRef& nxt, char* lds, Seam& S) {
    const int tid = threadIdx.x, wid = __builtin_amdgcn_readfirstlane(tid >> 6), lane = tid & 63, r32 = lane & 31, hi = lane >> 5;
    int j_hi = (cur.P0 + QB - 1) / KVBLK + 1; if (j_hi > cur.skv / KVBLK) j_hi = cur.skv / KVBLK;
    const int NT = j_hi;
    const int qlo = cur.P0 + wid * QBLK, qm = qlo + r32 - 4 * hi;
    const int qbm = MOBA ? cur.moba_qb : -1;
    char* V_lds = lds; char* K_lds = lds + NVB * SHM_V;
    float* ws = (float*)(lds + LDS_WS_OFF) + wid * 64; float* li_l = ws, * al_l = ws + 32;
    float m_reg = -1e30f, l_reg = 0; f32x16 o[4] = {};
    const int sr = tid >> 4, sc = (tid & 15) * 8, vst0 = v_st(sr, sc), vst1 = vst0 + 8192  , kws = KSWZ(sr, sc * 2);
    const int vb0 = (int)(uintptr_t)V_lds + v_rd_base(lane);
    const bf16* Kh = cur.K; const bf16* Vh = cur.V;
    unsigned sel = 0xffu;
    if (MOBA && qbm > 3) {
        const float* km = (const float*)(lds + LDS_KM_OFF) + cur.kmi * 1024 + hi * 8;
        const float NEGI = -__builtin_inff();
        float v1 = NEGI, v2 = NEGI, v3 = NEGI; unsigned b1 = 0u, b2 = 0u, b3 = 0u;
#pragma unroll 1
        for (int j = 0; j < qbm; ++j) {
            float a = 0.f;
#pragma unroll
            for (int d0 = 0; d0 < 8; ++d0) {
                const f32x4 k0 = *(const f32x4*)(km + j * 128 + d0 * 16), k1 = *(const f32x4*)(km + j * 128 + d0 * 16 + 4);
                const bf16x8 q = S.qr[d0];
#pragma unroll
                for (int e = 0; e < 4; ++e) { a = fmaf(__uint_as_float((unsigned)(unsigned short)q[e] << 16), k0[e], a); }
#pragma unroll
                for (int e = 0; e < 4; ++e) { a = fmaf(__uint_as_float((unsigned)(unsigned short)q[4 + e] << 16), k1[e], a); }
            }
            a += __shfl_xor(a, 32);
            const unsigned bj = 1u << j;
            const bool g1 = a > v1, g2 = a > v2, g3 = a > v3;
            v3 = g2 ? v2 : (g3 ? a : v3); b3 = g2 ? b2 : (g3 ? bj : b3);
            v2 = g1 ? v1 : (g2 ? a : v2); b2 = g1 ? b1 : (g2 ? bj : b2);
            v1 = g1 ? a : v1;             b1 = g1 ? bj : b1;
        }
        sel = b1 | b2 | b3;
    }
#if ATT_FIXEDMAX
#define PSM(P0_, P1_, mn_, al_) do { partialSM_fixed(P0_, P1_); al_ = 1.f; } while (0)
#define RESC(a) do { } while (0)
#else
#define PSM(P0_, P1_, mn_, al_) partialSM(P0_, P1_, m_reg, mn_, al_)
#define RESC(a) do { if (__any((a) < 1.f)) { if (hi == 0) al_l[r32] = (a); asm volatile("s_waitcnt lgkmcnt(0)" ::: "memory");              \
                     for (int d_ = 0; d_ < 4; ++d_) for (int r = 0; r < 16; ++r) o[d_][r] *= al_l[crow(r, hi)]; } } while (0)
#endif
#define KBASE(t) ((t) * KVBLK)
#define MASKT(P0_, P1_, t) do { const int kb_ = KBASE(t); if (kb_ + KVBLK - 1 > qlo) mask_tile(P0_, P1_, qm - kb_, WBIG); } while (0)
#define CINIT(t) (((MOBA && ((t) >> 2) < qbm && !((sel >> ((t) >> 2)) & 1u)) ? -__builtin_inff() : 0.f) + (ATT_FIXEDMAX ? cur.mnl : 0.f))
    constexpr int NQL = 8;
#define SEAM_K0() do { VMWN(NQL); SWRITE_HK(0); SBAR(); } while (0)
    f32x16 pA0, pA1, pB0, pB1; float mnA, mnB, alA, alB; bf16x8 pa0, pa1, pa2, pa3;
    SWRITE_HV(0); SBAR();
    if (NT > 1) { SLOAD_H(Kh, Vh, KBASE(1)); }
    SBAR(); qkt<0>(pA0, pA1, K_lds, r32, hi, S.qr, CINIT(0));
    MASKT(pA0, pA1, 0); PSM(pA0, pA1, mnA, alA);
    if (NT > 1) { VMW(); SWRITE_H(1, SHM_V); }
    __syncthreads();
    int vA = 0, vB = SHM_V, vC = 2 * SHM_V;
#define HALF_STEP(PX0, PX1, mnX, alX, PY0, PY1, alY, t, KB, SB) do {                                                             \
        SBAR(); if ((t) + 1 < NT) { SLOAD_H(Kh, Vh, KBASE((t) + 1)); SBAR(); }     \
        qkt<KB>(PX0, PX1, K_lds, r32, hi, S.qr, CINIT(t));                                                                    \
        finishSM(PY0, PY1, alY, l_reg, pa0, pa1, pa2, pa3); SBAR();                                                           \
        pv_tile<ATT_FIXEDMAX != 0>(o, vb0 + vA, pa0, pa1, pa2, pa3, PX0);     \
        if (ATT_FIXEDMAX) { const int kb_ = KBASE(t); if (kb_ + KVBLK - 1 > qlo) mask_tile_post(PX0, PX1, qm - kb_, WBIG); alX = 1.f; } else { MASKT(PX0, PX1, (t)); PSM(PX0, PX1, mnX, alX); }   \
          \
        if ((t) + 1 < NT) { VMW(); SWRITE_H(SB, vC); }                                                                        \
        RESC(alX); { const int v_ = vA; vA = vB; vB = vC; vC = v_; } __syncthreads(); } while (0)
    for (int t = 1; t + 1 < NT; t += 2) {
        HALF_STEP(pB0, pB1, mnB, alB, pA0, pA1, alA, t, 1, 0);
        HALF_STEP(pA0, pA1, mnA, alA, pB0, pB1, alB, t + 1, 0, 1);
    }
    const bool even = (NT & 1) == 0;
    if (even) { SBAR(); qkt<1>(pB0, pB1, K_lds, r32, hi, S.qr, CINIT(NT - 1)); SBAR(); }
    SLOAD_H(nxt.K, nxt.V, 0); SBAR();
#pragma unroll
    for (int d0 = 0; d0 < 8; ++d0) S.qr[d0] = load8(nxt.Q + (size_t)(wid * QBLK + r32) * PQ + d0 * 16 + hi * 8);
    SBAR();
    finishSM(pA0, pA1, alA, l_reg, pa0, pa1, pa2, pa3); SBAR();
    pv_tile<false>(o, vb0 + vA, pa0, pa1, pa2, pa3, pA0);
    if (even) { MASKT(pB0, pB1, NT - 1); PSM(pB0, pB1, mnB, alB); __syncthreads(); RESC(alB);
        finishSM(pB0, pB1, alB, l_reg, pa0, pa1, pa2, pa3); SBAR(); pv_tile<false>(o, vb0 + vB, pa0, pa1, pa2, pa3, pB0); }
    SBAR(); SEAM_K0();
    const float rl_ = __builtin_amdgcn_rcpf(l_reg);
    int wq_ = wid; asm volatile("" : "+s"(wq_));
    unsigned loff_ = (unsigned)(r32 * PO) * 2u + (unsigned)hi * 16u; asm volatile("" : "+v"(loff_));
    char* Ob = (char*)(cur.O + (size_t)(wq_ * QBLK) * PO);
#pragma unroll
    for (int d0 = 0; d0 < 4; ++d0)
#pragma unroll
        for (int g = 0; g < 4; g += 2) {
            unsigned ax = cvtpk(o[d0][4 * g] * rl_, o[d0][4 * g + 1] * rl_), ay = cvtpk(o[d0][4 * g + 2] * rl_, o[d0][4 * g + 3] * rl_);
            unsigned bx = cvtpk(o[d0][4 * g + 4] * rl_, o[d0][4 * g + 5] * rl_), by = cvtpk(o[d0][4 * g + 6] * rl_, o[d0][4 * g + 7] * rl_);
            { auto r0 = __builtin_amdgcn_permlane32_swap(ax, bx, false, false); ax = r0[0]; bx = r0[1]; }
            { auto r1 = __builtin_amdgcn_permlane32_swap(ay, by, false, false); ay = r1[0]; by = r1[1]; }
            u32x4 w = {ax, ay, bx, by};
            *(u32x4*)(Ob + (d0 * 32 + 8 * g) * 2 + loff_) = w; }
    __syncthreads();
#undef RESC
#undef PSM
#undef KBASE
#undef MASKT
#undef CINIT
#undef SEAM_K0
#undef HALF_STEP
}
#undef ROWP
#undef VMW
#undef VMWN
#undef SLOAD_H
#undef SWRITE_HK
#undef SWRITE_HV
#undef SWRITE_H
#undef KSWZ
#undef SBAR
}

#define GAS __attribute__((address_space(1)))
#define LAS __attribute__((address_space(3)))
typedef unsigned short bf16;
typedef unsigned v4u __attribute__((ext_vector_type(4)));
typedef float f32x4 __attribute__((ext_vector_type(4)));
typedef short bf16x8 __attribute__((ext_vector_type(8)));
typedef GAS unsigned gu32;
typedef GAS unsigned long long gu64;
#define RLX_AGENT __ATOMIC_RELAXED, __HIP_MEMORY_SCOPE_AGENT
#define LDS_WAIT() asm volatile("s_waitcnt lgkmcnt(0)" ::: "memory")
#define VM_WAIT() asm volatile("s_waitcnt vmcnt(0)" ::: "memory")
__device__ __forceinline__ unsigned long long rt() { return __builtin_amdgcn_s_memrealtime(); }
__device__ __forceinline__ unsigned f2bf(float f) { unsigned u = __builtin_bit_cast(unsigned, f); return (u + 0x7fffu + ((u >> 16) & 1u)) >> 16; }
__device__ __forceinline__ unsigned pk2(float lo, float hi) { return f2bf(lo) | (f2bf(hi) << 16); }

#define XB_TMO      128
#define XB_XCNT(j)  (256  + 64 * (j))
#define XB_XSUB(j)  (1280 + 64 * (j))
#define XB_XGEN(j)  (2304 + 64 * (j))
#define XB_TOP      3328
#define XB_TOPGEN   3392
#define XCD_BAR_WORDS 3456
#define XB_SPIN_CAP (1u << 18)

__device__ __forceinline__ unsigned xb_ld(unsigned* p)              { return __hip_atomic_load(p, __ATOMIC_RELAXED, __HIP_MEMORY_SCOPE_AGENT); }
__device__ __forceinline__ unsigned xb_add(unsigned* p, unsigned v) { return __hip_atomic_fetch_add(p, v, __ATOMIC_RELAXED, __HIP_MEMORY_SCOPE_AGENT); }
__device__ __forceinline__ unsigned xb_xcc_id() { return (unsigned)__builtin_amdgcn_s_getreg((3 << 11) | 20) & 0xFu; }
#define XB_SPIN(cond, bar) do { unsigned _sp = 0; while (cond) { __builtin_amdgcn_s_sleep(1); \
    if ((++_sp & 255u) == 0u) { if (xb_ld(&(bar)[XB_TMO])) break; if (_sp > XB_SPIN_CAP) { atomicAdd(&(bar)[XB_TMO], 1u); break; } } } } while (0)

struct XcdBarrier {
    unsigned* bar; unsigned x;
    volatile LAS unsigned* st;
};

__device__ __forceinline__ XcdBarrier xcd_barrier_post(unsigned* bar, volatile LAS unsigned* st) {
    XcdBarrier b; b.bar = bar; b.x = xb_xcc_id(); b.st = st;
    if (threadIdx.x == 0) (void)xb_add(&bar[XB_XCNT(b.x)], 1u);
    return b;
}
__device__ __forceinline__ void xcd_barrier_complete(unsigned* bar, unsigned x, unsigned& nloc, unsigned& nx) {
    const unsigned G = gridDim.x * gridDim.y * gridDim.z;
    unsigned sum, cnt, mine, sp = 0u;
    for (;;) {
        sum = 0u; cnt = 0u; mine = 0u;
#pragma unroll
        for (unsigned j = 0; j < 16; ++j) { const unsigned c = xb_ld(&bar[XB_XCNT(j)]); sum += c; cnt += (c > 0u) ? 1u : 0u; mine = (j == x) ? c : mine; }
        if (sum == G) break;
        __builtin_amdgcn_s_sleep(1);
        if ((++sp & 255u) == 0u) { if (xb_ld(&bar[XB_TMO])) break; if (sp > XB_SPIN_CAP) { atomicAdd(&bar[XB_TMO], 1u); break; } }
    }
    nloc = mine > 0u ? mine : 1u; nx = cnt > 0u ? cnt : 1u;
}

__device__ __forceinline__ void xcd_barrier(const XcdBarrier& b) {
    asm volatile("s_waitcnt vmcnt(0)" ::: "memory");
    __syncthreads();
    if (threadIdx.x == 0) {
        unsigned* bar = b.bar;
        __builtin_amdgcn_s_waitcnt(0);
        unsigned nloc = b.st[0], nx = b.st[1];
        if (nloc == 0u) { xcd_barrier_complete(bar, b.x, nloc, nx); b.st[0] = nloc; b.st[1] = nx; }
        const unsigned old = xb_add(&bar[XB_XSUB(b.x)], 1u);
        const unsigned gen = old / nloc;
        if (old + 1u == (gen + 1u) * nloc) {
            __builtin_amdgcn_fence(__ATOMIC_RELEASE, "agent");
            asm volatile("s_waitcnt vmcnt(0)" ::: "memory");
            const unsigned og = xb_add(&bar[XB_TOP], 1u);
            const unsigned tg = og / nx;
            if (og + 1u == (tg + 1u) * nx) xb_add(&bar[XB_TOPGEN], 1u);
            else XB_SPIN(xb_ld(&bar[XB_TOPGEN]) == tg, bar);
            __builtin_amdgcn_fence(__ATOMIC_ACQUIRE, "agent");
            xb_add(&bar[XB_XGEN(b.x)], 1u);
            asm volatile("s_waitcnt vmcnt(0)" ::: "memory");
        } else {
            XB_SPIN(xb_ld(&bar[XB_XGEN(b.x)]) == gen, bar);
            __builtin_amdgcn_fence(__ATOMIC_ACQUIRE, "agent");
            asm volatile("s_waitcnt vmcnt(0)" ::: "memory");
        }
    }
    __syncthreads();
}


constexpr int NWAVES = 8;
#ifndef MK_N_LAUNCHES
#define MK_N_LAUNCHES 1
#endif
constexpr int NPH = 14;
constexpr int N_LAUNCHES = MK_N_LAUNCHES;
static_assert(N_LAUNCHES == 1 || N_LAUNCHES == NPH, "MK_N_LAUNCHES is 1 or NPH");

constexpr int BATCH = 8, SEQ = 2048, DM = 4096, M = BATCH * SEQ;
constexpr int NIN = 12288, FF = 11008, NGU = 2 * FF, MEML = 256, MM = BATCH * MEML, MW = 512, NKV = 2 * MW;
constexpr int C_QA = 0, C_KA = 2048, C_VA = 4096, C_QB = 6144, C_KB = 8192, C_VB = 10240;
constexpr float NORM_EPS = 1e-6f;
constexpr float LAM_INIT = 0.2f;

constexpr size_t MiB = 1u << 20;
constexpr size_t WS_CTL = 0, CTL_ZERO_BYTES = 64 * 1024;
constexpr size_t WS_ROPE = 1 * MiB;
constexpr size_t WS_KMEAN = WS_ROPE + 512 * 1024;
constexpr size_t WS_W_IN = 2 * MiB;
constexpr size_t WS_W_OUT = WS_W_IN + (size_t)NIN * DM * 2;
constexpr size_t WS_W_MQ = WS_W_OUT + (size_t)DM * DM * 2;
constexpr size_t WS_W_MKV = WS_W_MQ + (size_t)MW * DM * 2;
constexpr size_t WS_W_MO = WS_W_MKV + (size_t)NKV * DM * 2;
constexpr size_t WS_W_GU = WS_W_MO + (size_t)DM * MW * 2;
constexpr size_t WS_W_DN = WS_W_GU + (size_t)NGU * DM * 2;
constexpr size_t WS_XN = WS_W_DN + (size_t)DM * FF * 2;
constexpr size_t WS_PROJ = WS_XN + (size_t)M * DM * 2;
constexpr size_t WS_MIX = WS_PROJ + (size_t)M * NIN * 2;
constexpr size_t WS_MEMN = WS_MIX + (size_t)M * DM * 2;
constexpr size_t WS_KVC = WS_MEMN + (size_t)MM * DM * 2;
constexpr size_t WS_PS = WS_KVC + (size_t)MM * NKV * 2;
constexpr size_t WS_RS = WS_PS + (size_t)2 * M * 64 * 4;
constexpr size_t WS_END = WS_RS + (size_t)2 * M * 4;
static_assert(WS_W_IN % MiB == 0 && WS_XN % 256 == 0 && WS_END <= 1140000000ull, "d_ws map");
constexpr int CW_TMO = 0, CW_CODE = 1;
constexpr int CW_BAR = 4096;
static_assert((CW_BAR + 2 * XCD_BAR_WORDS) * 4 <= (int)CTL_ZERO_BYTES, "both barrier regions inside the per-call memset");

constexpr int RING_OFF = 0, RING_BYTES = 131072;
constexpr int LDSCTL_OFF = RING_BYTES, MISC_OFF = LDSCTL_OFF + 320;
constexpr int EPIX_OFF = MISC_OFF + 128;
constexpr int LDS_BYTES = 147456;
static_assert(EPIX_OFF % 16 == 0 && EPIX_OFF + 12288 <= LDS_BYTES && att::LDS_BYTES <= RING_BYTES, "LDS map");

__device__ __forceinline__ float wave_sum(float v) {
#pragma unroll
    for (int o = 1; o < 64; o <<= 1) v += __shfl_xor(v, o);
    return v;
}
__device__ __forceinline__ float bf2f(unsigned short s) { return __uint_as_float((unsigned)s << 16); }
__device__ __forceinline__ unsigned pk4_fp8(float a, float b, float c, float d) { int w = __builtin_amdgcn_cvt_pk_fp8_f32(a, b, 0, false); w = __builtin_amdgcn_cvt_pk_fp8_f32(c, d, w, true); return (unsigned)w; }
__device__ __forceinline__ void p0_transpose_item(const float* W, int K, int N, bf16* WT, int k0, int n0, int orow0, LAS float* scr, int lane, const float* gk = nullptr, unsigned char* WT8 = nullptr) {
    const int lr = lane >> 4, n4 = lane & 15;
    f32x4 v[16];
#pragma unroll
    for (int i = 0; i < 16; ++i) v[i] = *(const GAS f32x4*)(W + (size_t)(k0 + 4 * i + lr) * N + n0 + 4 * n4);
    const int c = lane & 7, nn = lane >> 3;
    f32x4 ga = {1.f, 1.f, 1.f, 1.f}, gb = {1.f, 1.f, 1.f, 1.f};
    if (gk) { ga = *(const f32x4*)(gk + k0 + 8 * c); gb = *(const f32x4*)(gk + k0 + 8 * c + 4); }
#pragma unroll
    for (int i = 0; i < 16; ++i) { const int k = 4 * i + lr; *(LAS f32x4*)(scr + k * 64 + ((4 * n4) ^ (((k >> 3) & 7) << 2))) = v[i]; }
    LDS_WAIT(); asm volatile("" ::: "memory");
#pragma unroll
    for (int j = 0; j < 8; ++j) { const int n = nn + 8 * j; const LAS float* s = scr + (8 * c) * 64 + (n ^ (c << 2));
        v4u o; o.x = pk2(s[0 * 64] * ga.x, s[1 * 64] * ga.y); o.y = pk2(s[2 * 64] * ga.z, s[3 * 64] * ga.w); o.z = pk2(s[4 * 64] * gb.x, s[5 * 64] * gb.y); o.w = pk2(s[6 * 64] * gb.z, s[7 * 64] * gb.w);
        if (WT8) { *(GAS unsigned long long*)(WT8 + (size_t)(orow0 + n) * K + k0 + 8 * c) = (unsigned long long)pk4_fp8(s[0 * 64] * 256.f, s[1 * 64] * 256.f, s[2 * 64] * 256.f, s[3 * 64] * 256.f) | ((unsigned long long)pk4_fp8(s[4 * 64] * 256.f, s[5 * 64] * 256.f, s[6 * 64] * 256.f, s[7 * 64] * 256.f) << 32); continue; }
        *(GAS v4u*)(WT + (size_t)(orow0 + n) * K + k0 + 8 * c) = o; }
    LDS_WAIT(); asm volatile("" ::: "memory");
}
__device__ __forceinline__ void rms_row_to_bf16(const float* xrow, const float* g, bf16* orow, int lane, unsigned char* o8row = nullptr) {
    const GAS f32x4* xr = (const GAS f32x4*)xrow + lane; const GAS f32x4* gr = (const GAS f32x4*)g + lane;
    f32x4 v[16]; float s = 0.f;
#pragma unroll
    for (int j = 0; j < 16; ++j) { v[j] = xr[64 * j]; s += (v[j].x * v[j].x + v[j].y * v[j].y) + (v[j].z * v[j].z + v[j].w * v[j].w); }
    const float rs = 1.0f / sqrtf(wave_sum(s) * (1.f / DM) + NORM_EPS);
    GAS unsigned long long* o8 = (GAS unsigned long long*)orow + lane;
#pragma unroll
    for (int j = 0; j < 16; ++j) { const f32x4 gg = gr[64 * j];
        o8[64 * j] = (unsigned long long)pk2(v[j].x * rs * gg.x, v[j].y * rs * gg.y) | ((unsigned long long)pk2(v[j].z * rs * gg.z, v[j].w * rs * gg.w) << 32);
        if (o8row) ((GAS unsigned*)o8row)[64 * j + lane] = pk4_fp8(v[j].x * rs * gg.x, v[j].y * rs * gg.y, v[j].z * rs * gg.z, v[j].w * rs * gg.w); }
}
__device__ __forceinline__ void normrope_unit(bf16* T, int pitch, int row0, int c0, const float* g, const float* rope, float* km, LAS float* scr, int tid) {
    const int wave = tid >> 6, lane = tid & 63, rsub = lane >> 4, c = lane & 15;
    float gv[8];
    { const f32x4 g0 = *(const f32x4*)(g + 8 * c), g1 = *(const f32x4*)(g + 8 * c + 4); gv[0] = g0.x; gv[1] = g0.y; gv[2] = g0.z; gv[3] = g0.w; gv[4] = g1.x; gv[5] = g1.y; gv[6] = g1.z; gv[7] = g1.w; }
    float csum[8];
#pragma unroll
    for (int e = 0; e < 8; ++e) csum[e] = 0.f;
#pragma unroll 2
    for (int it = 0; it < 8; ++it) {
        const int r = row0 + wave * 32 + it * 4 + rsub;
        bf16* p = T + (size_t)r * pitch + c0 + 8 * c;
        const v4u raw = *(const v4u*)p;
        float y[8];
        y[0] = __uint_as_float(raw.x << 16); y[1] = __uint_as_float(raw.x & 0xffff0000u); y[2] = __uint_as_float(raw.y << 16); y[3] = __uint_as_float(raw.y & 0xffff0000u);
        y[4] = __uint_as_float(raw.z << 16); y[5] = __uint_as_float(raw.z & 0xffff0000u); y[6] = __uint_as_float(raw.w << 16); y[7] = __uint_as_float(raw.w & 0xffff0000u);
        float ss = 0.f;
#pragma unroll
        for (int e = 0; e < 8; ++e) ss += y[e] * y[e];
        ss += __shfl_xor(ss, 1); ss += __shfl_xor(ss, 2); ss += __shfl_xor(ss, 4); ss += __shfl_xor(ss, 8);
        const float rs = 1.0f / sqrtf(ss * (1.f / 128.f) + NORM_EPS);
#pragma unroll
        for (int e = 0; e < 8; ++e) y[e] = y[e] * rs * gv[e];
        if (rope) {
            float pr[8];
#pragma unroll
            for (int e = 0; e < 8; ++e) pr[e] = __shfl_xor(y[e], 2);
            if (c < 4) {
                const float* cs = rope + (size_t)(r & (SEQ - 1)) * 32 + (c & 1) * 8;
                const f32x4 c0v = *(const f32x4*)cs, c1v = *(const f32x4*)(cs + 4), s0v = *(const f32x4*)(cs + 16), s1v = *(const f32x4*)(cs + 20);
                const float cc[8] = {c0v.x, c0v.y, c0v.z, c0v.w, c1v.x, c1v.y, c1v.z, c1v.w}, sn[8] = {s0v.x, s0v.y, s0v.z, s0v.w, s1v.x, s1v.y, s1v.z, s1v.w};
                const float sg = (c < 2) ? -1.f : 1.f;
#pragma unroll
                for (int e = 0; e < 8; ++e) y[e] = y[e] * cc[e] + sg * pr[e] * sn[e];
            }
        }
#pragma unroll
        for (int e = 0; e < 8; ++e) csum[e] += y[e];
        v4u o; o.x = pk2(y[0], y[1]); o.y = pk2(y[2], y[3]); o.z = pk2(y[4], y[5]); o.w = pk2(y[6], y[7]);
        *(v4u*)p = o;
    }
    if (km) {
#pragma unroll
        for (int e = 0; e < 8; ++e) { csum[e] += __shfl_xor(csum[e], 16); csum[e] += __shfl_xor(csum[e], 32); }
        if (rsub == 0) {
#pragma unroll
            for (int e = 0; e < 8; ++e) scr[wave * 128 + 8 * c + e] = csum[e]; }
        __syncthreads();
        if (tid < 128) { float s = 0.f;
#pragma unroll
            for (int w = 0; w < 8; ++w) s += scr[w * 128 + tid];
            km[tid] = s * (1.f / 256.f); }
        __syncthreads();
    }
}


__device__ __forceinline__ bf16* hm_addr(bf16* T, int ch, int b, int s) { return T + ((size_t)(ch * BATCH + b) * SEQ + s) * 128; }
__device__ __forceinline__ float att_mnl(const float* gq, const float* gk, int lane) {
    float a = fmaxf(fabsf(gq[lane]), fabsf(gq[lane + 64])), b = fmaxf(fabsf(gk[lane]), fabsf(gk[lane + 64]));
#pragma unroll
    for (int o = 1; o < 64; o <<= 1) { a = fmaxf(a, __shfl_xor(a, o)); b = fmaxf(b, __shfl_xor(b, o)); }
    return __int_as_float(__builtin_amdgcn_readfirstlane(__float_as_int(-(128.0f * a * b * 1.03f) * (1.4426950408889634f * att::SCALE))));
}
__device__ __forceinline__ att::BlockRef attn_get(int idx, int G, int vcu, bf16* PROJ_, bf16* MIX_, bf16* DO_, float mnl_diff, float mnl_moba) {
    att::BlockRef r;
    if (idx < 8) { const int b = vcu >> 5, dh = (vcu >> 2) & 7, xq = vcu & 3, pass = idx >> 2, sub = idx & 3, s = sub >> 1, vh = (sub & 1) ^ s, qb = pass ? 7 - xq : xq;
        const size_t rq = (size_t)b * SEQ + (size_t)qb * 256;
        r.Q = hm_addr(PROJ_, 48 + 2 * dh + s, b, qb * 256); r.K = hm_addr(PROJ_, 64 + 2 * dh + s, b, 0); r.V = hm_addr(PROJ_, 80 + 2 * dh + vh, b, 0);
        r.O = DO_ + rq * DM + dh * 512 + s * 256 + vh * 128; r.moba_qb = -1; r.kmi = 0; r.P0 = qb * 256; r.mnl = mnl_diff; }
    else { const int mi = (idx - 8) >> 1, pass = idx & 1, I = mi * G + vcu, xq = I & 3, hm = I >> 2, b = hm >> 4, hu = hm & 15, qb = pass ? 7 - xq : xq;
        const size_t rq = (size_t)b * SEQ + (size_t)qb * 256;
        r.Q = hm_addr(PROJ_, hu, b, qb * 256); r.K = hm_addr(PROJ_, 16 + hu, b, 0); r.V = hm_addr(PROJ_, 32 + hu, b, 0); r.O = MIX_ + rq * DM + hu * 128;
        r.moba_qb = qb; r.kmi = mi; r.P0 = qb * 256; r.mnl = mnl_moba; }
    r.skv = SEQ;
    return r;
}

struct Args { const float* in[26]; float* out; float* outw; unsigned char* ws; int ph_lo, ph_hi, li, pad; };
#define KAS __attribute__((address_space(4)))
__device__ __forceinline__ const KAS Args* kargs() { const KAS Args* p = (const KAS Args*)__builtin_amdgcn_kernarg_segment_ptr(); asm volatile("" : "+s"(p)); return p; }
#define KARGS (kargs())
#define A_IN(k) (KARGS->in[k])
#define PS_CROSS ((float*)(ws + WS_PS))
#define PS_FFN ((float*)(ws + WS_PS) + (size_t)M * 64)
#define RS_CROSS ((float*)(ws + WS_RS))
#define RS_FFN ((float*)(ws + WS_RS) + M)
#define ROPE ((float*)(ws + WS_ROPE))
#define KMEAN ((float*)(ws + WS_KMEAN))
#define W_IN ((bf16*)(ws + WS_W_IN))
#define W_OUT ((bf16*)(ws + WS_W_OUT))
#define W_MQ ((bf16*)(ws + WS_W_MQ))
#define W_MKV ((bf16*)(ws + WS_W_MKV))
#define W_MO ((bf16*)(ws + WS_W_MO))
#define W_GU ((bf16*)(ws + WS_W_GU))
#define W_DN ((bf16*)(ws + WS_W_DN))
#define XN ((bf16*)(ws + WS_XN))
#define PROJ ((bf16*)(ws + WS_PROJ))
#define MIX ((bf16*)(ws + WS_MIX))
#define XN8 ((unsigned char*)(ws + WS_MIX))
#define W_IN8 ((unsigned char*)(ws + WS_MIX + 96 * MiB))
#define MEMN ((bf16*)(ws + WS_MEMN))
#define KVC ((bf16*)(ws + WS_KVC))
#define DO XN
#define HB PROJ
#define QC MIX
#define OC (MIX + (size_t)16 * MiB / 2)

constexpr int CV_I_IN = (DM / 64) * (NIN / 64), CV_I_OUT = (DM / 64) * (DM / 64), CV_I_MQ = (DM / 64) * (MW / 64), CV_I_MO = (MW / 64) * (DM / 64), CV_I_G = (DM / 64) * (FF / 64), CV_I_DN = (FF / 64) * (DM / 64);
constexpr int CV_S_GU = CV_I_IN + CV_I_OUT + 3 * CV_I_MQ + CV_I_MO, CV_S_DN = CV_S_GU + 2 * CV_I_G, CV_NITEMS = CV_S_DN + CV_I_DN;
constexpr int CV_GU_P7 = 96 * 8 * 9, CV_DN_P12 = 128 * 8 * 10;
constexpr int CV_P0_A = CV_S_DN - CV_GU_P7, CV_DN_P0 = CV_I_DN - CV_DN_P12;
static_assert(CV_P0_A > CV_S_GU && CV_DN_P0 >= 0, "conversion split");
__device__ __forceinline__ void convert_item(int it, unsigned char* ws, LAS float* scr, int lane) {
    int r = it;
    if (r < CV_I_IN) { const int nb = NIN / 64, kb = r / nb, n0 = 64 * (r % nb); const bool f8 = n0 < 6144;
        p0_transpose_item(A_IN(3), DM, NIN, W_IN, 64 * kb, n0, n0, scr, lane, nullptr, f8 ? W_IN8 : nullptr); return; } r -= CV_I_IN;
    if (r < CV_I_OUT) { const int nb = DM / 64, kb = r / nb, n0 = 64 * (r % nb); p0_transpose_item(A_IN(13), DM, DM, W_OUT, 64 * kb, n0, n0, scr, lane); return; } r -= CV_I_OUT;
    if (r < CV_I_MQ) { const int nb = MW / 64, kb = r / nb, n0 = 64 * (r % nb); p0_transpose_item(A_IN(16), DM, MW, W_MQ, 64 * kb, n0, n0, scr, lane, A_IN(14)); return; } r -= CV_I_MQ;
    if (r < CV_I_MQ) { const int nb = MW / 64, kb = r / nb, n0 = 64 * (r % nb); p0_transpose_item(A_IN(17), DM, MW, W_MKV, 64 * kb, n0, n0, scr, lane); return; } r -= CV_I_MQ;
    if (r < CV_I_MQ) { const int nb = MW / 64, kb = r / nb, n0 = 64 * (r % nb); p0_transpose_item(A_IN(18), DM, MW, W_MKV, 64 * kb, n0, MW + n0, scr, lane); return; } r -= CV_I_MQ;
    if (r < CV_I_MO) { const int nb = DM / 64, kb = r / nb, n0 = 64 * (r % nb); p0_transpose_item(A_IN(19), MW, DM, W_MO, 64 * kb, n0, n0, scr, lane); return; } r -= CV_I_MO;
    if (r < CV_I_G) { const int nb = FF / 64, kb = r / nb, n0 = 64 * (r % nb); p0_transpose_item(A_IN(23), DM, FF, W_GU, 64 * kb, n0, 256 * (n0 / 128) + (n0 % 128), scr, lane, A_IN(22)); return; } r -= CV_I_G;
    if (r < CV_I_G) { const int nb = FF / 64, kb = r / nb, n0 = 64 * (r % nb); p0_transpose_item(A_IN(24), DM, FF, W_GU, 64 * kb, n0, 256 * (n0 / 128) + 128 + (n0 % 128), scr, lane, A_IN(22)); return; } r -= CV_I_G;
    { const int nb = DM / 64, kb = r / nb, n0 = 64 * (r % nb); p0_transpose_item(A_IN(25), FF, DM, W_DN, 64 * kb, n0, n0, scr, lane); }
}
#ifndef STAGGER_STEP
#define STAGGER_STEP 6
#endif
__device__ __forceinline__ void phase_stagger(int vcu) { for (int i = 0; i < (vcu & 31); ++i) __builtin_amdgcn_s_sleep(STAGGER_STEP); }
__device__ __forceinline__ void rs_panel(const float* PS, float* RS, int pm, int tid) {
    const int row = pm * 256 + (tid >> 1), half = tid & 1;
    const f32x4* p = (const f32x4*)(PS + (size_t)row * 64 + half * 32);
    float s = 0.f;
#pragma unroll
    for (int j = 0; j < 8; ++j) { const f32x4 v = p[j]; s += (v.x + v.y) + (v.z + v.w); }
    s += __shfl_xor(s, 1);
    if (!half) RS[row] = 1.0f / sqrtf(s * (1.f / DM) + NORM_EPS);
}
__global__ void __launch_bounds__(NWAVES * 64, 2) mk_fwd(Args args_unused) {
    extern __shared__ __attribute__((aligned(16))) unsigned char lds[];
    LAS unsigned char* const ldsL = (LAS unsigned char*)lds;
    volatile LAS unsigned* const MISC = (volatile LAS unsigned*)(ldsL + MISC_OFF);
    const int tid = threadIdx.x, lane = tid & 63, wave = __builtin_amdgcn_readfirstlane(tid >> 6);
    const int G = gridDim.x, bx = blockIdx.x, vcu = (G % 8 == 0) ? (bx % 8) * (G / 8) + bx / 8 : bx;
    unsigned char* const ws = KARGS->ws;
    gu32* const ctl = (gu32*)(ws + WS_CTL);
#define XIN (A_IN(0))
#define OUTR (KARGS->out)
#define OUTW (KARGS->outw)
    for (int u = tid; u < (LDS_BYTES - LDSCTL_OFF) / 4; u += NWAVES * 64) ((LAS unsigned*)(ldsL + LDSCTL_OFF))[u] = 0u;
    __syncthreads();
    XcdBarrier bar; bar.bar = (unsigned*)(ctl + CW_BAR) + KARGS->li * XCD_BAR_WORDS; bar.x = 0; bar.st = nullptr;
    if (N_LAUNCHES == 1) bar = xcd_barrier_post((unsigned*)(ctl + CW_BAR) + KARGS->li * XCD_BAR_WORDS, MISC + 8);
#define GRID_BAR(seam) do { if (N_LAUNCHES != 1) { if (tid == 0) __hip_atomic_store(ctl + CW_TMO, 0xBADBA0u | (unsigned)(seam), RLX_AGENT); } else { xcd_barrier(bar); } } while (0)
    const int lo = KARGS->ph_lo, hi = KARGS->ph_hi;
#ifndef PH_MASK
#define PH_MASK 0x3fff
#endif
#define IN(k) ((((PH_MASK) >> (k)) & 1) && lo <= (k) && (k) < hi)
#define BOTH(k) (IN(k) && IN((k) + 1))
    const int gw = vcu * NWAVES + wave, NGW = G * NWAVES;

    if (IN(0)) {
        LAS float* scr = (LAS float*)(ldsL + RING_OFF + wave * 16384);
        for (int it = gw; it < CV_P0_A; it += NGW) convert_item(it, ws, scr, lane);
        for (int it = CV_S_DN + gw; it < CV_S_DN + CV_DN_P0; it += NGW) convert_item(it, ws, scr, lane);
        for (int m = gw; m < M; m += NGW) rms_row_to_bf16(XIN + (size_t)m * DM, A_IN(2), XN + (size_t)m * DM, lane, XN8 + (size_t)m * DM);
        for (int m = gw; m < MM; m += NGW) rms_row_to_bf16(A_IN(1) + (size_t)m * DM, A_IN(15), MEMN + (size_t)m * DM, lane);
        if (BOTH(0)) GRID_BAR(0);
    }
    if (IN(1)) {
        pg8::Gemm g{XN, W_IN, M, NIN - 6144, DM}; pg8::OrderSkip S; S.init(M, NIN - 6144, G, bx); S.lo = 0; S.add = 24;
        { LAS float* gt = (LAS float*)(ldsL + EPIX_OFF + 10240); const int k = tid >> 7; const float* gsrc = k == 0 ? A_IN(4) : k == 1 ? A_IN(5) : k == 2 ? A_IN(6) : A_IN(7); gt[tid] = gsrc[tid & 127]; __syncthreads(); }
        pg8::EpiHeads<pg8::PolProj> E{PROJ, KMEAN, nullptr, ldsL + EPIX_OFF};
        pg8::gemm_phase<pg8::EpiHeads<pg8::PolProj>, pg8::OrderSkip, true, PG8_SP2>(ldsL + RING_OFF, g, S, E);
        {
          pg8::Gemm g8{(const pg8::bf16_t*)XN8, (const pg8::bf16_t*)W_IN8, M, 6144, DM / 2}; pg8::OrderSkip S8; S8.init(M, 6144, G, bx); S8.lo = 0; S8.add = 0;
          pg8::EpiHeads<pg8::PolProj8> E8{PROJ, KMEAN, nullptr, ldsL + EPIX_OFF};
          int t2 = threadIdx.x; asm volatile("" : "+v"(t2));
          pg8::gemm_phase<pg8::EpiHeads<pg8::PolProj8>, pg8::OrderSkip, true, PG8_SP2, false, true>(ldsL + RING_OFF, g8, S8, E8, t2); }
        if (BOTH(1)) GRID_BAR(1);
    }
    if (IN(3)) {
        const float mnl_d_ = att_mnl(A_IN(6), A_IN(7), lane), mnl_m_ = att_mnl(A_IN(4), A_IN(5), lane);
#define get(idx) attn_get((idx), G, vcu, PROJ, MIX, DO, mnl_d_, mnl_m_)
        if (G == 256) {
            {
                float* kmL = (float*)((char*)lds + RING_OFF + att::LDS_KM_OFF);
#pragma unroll
                for (int mi = 0; mi < 2; ++mi) { const int hm = (mi * G + vcu) >> 2; const float* km = KMEAN + (size_t)hm * 8 * 128;
                    kmL[mi * 1024 + tid] = km[tid]; kmL[mi * 1024 + 512 + tid] = km[512 + tid]; }
            }
            att::BlockRef cur = get(0); att::Seam S; att::attn_prime<128, 128, DM, true>(cur, (char*)lds + RING_OFF, S);
            for (int i = 0; i < 12; ++i) { const att::BlockRef nxt = (i + 1 < 12) ? get(i + 1) : cur; att::attn_block<128, 128, DM, true>(cur, nxt, (char*)lds + RING_OFF, S); cur = nxt; }
            VM_WAIT(); __syncthreads();
            float lam;
            { const float a = A_IN(8)[lane] * A_IN(9)[lane] + A_IN(8)[lane + 64] * A_IN(9)[lane + 64];
              const float b = A_IN(10)[lane] * A_IN(11)[lane] + A_IN(10)[lane + 64] * A_IN(11)[lane + 64];
              lam = expf(wave_sum(a)) - expf(wave_sum(b)) + LAM_INIT; }
            const int half = lane >> 5, l5 = lane & 31, gb = vcu >> 5, gdh = (vcu >> 2) & 7, gx = vcu & 3;
            float gv[8];
            { const f32x4 g0 = *(const f32x4*)(A_IN(12) + 8 * l5), g1 = *(const f32x4*)(A_IN(12) + 8 * l5 + 4); gv[0] = g0.x; gv[1] = g0.y; gv[2] = g0.z; gv[3] = g0.w; gv[4] = g1.x; gv[5] = g1.y; gv[6] = g1.z; gv[7] = g1.w; }
            for (int it0 = 0; it0 < 32; it0 += 8) {
                v4u av[8], bv[8];
#pragma unroll
                for (int k = 0; k < 8; ++k) { const int rr = ((it0 + k) * NWAVES + wave) * 2 + half, qb = (rr < 256) ? gx : 7 - gx; const size_t row = (size_t)gb * SEQ + (size_t)qb * 256 + (rr & 255);
                    const bf16* p1 = DO + row * DM + gdh * 512 + 8 * l5; av[k] = *(const v4u*)p1; bv[k] = *(const v4u*)(p1 + 256); }
#pragma unroll
                for (int k = 0; k < 8; ++k) { const int rr = ((it0 + k) * NWAVES + wave) * 2 + half, qb = (rr < 256) ? gx : 7 - gx; const size_t row = (size_t)gb * SEQ + (size_t)qb * 256 + (rr & 255);
                    const unsigned aw[4] = {av[k].x, av[k].y, av[k].z, av[k].w}, bw[4] = {bv[k].x, bv[k].y, bv[k].z, bv[k].w};
                    float o[8]; float ss = 0.f;
#pragma unroll
                    for (int e = 0; e < 4; ++e) { o[2 * e] = __uint_as_float(aw[e] << 16) - lam * __uint_as_float(bw[e] << 16); o[2 * e + 1] = __uint_as_float(aw[e] & 0xffff0000u) - lam * __uint_as_float(bw[e] & 0xffff0000u); }
#pragma unroll
                    for (int e = 0; e < 8; ++e) ss += o[e] * o[e];
                    ss += __shfl_xor(ss, 1); ss += __shfl_xor(ss, 2); ss += __shfl_xor(ss, 4); ss += __shfl_xor(ss, 8); ss += __shfl_xor(ss, 16);
                    const float rs = (1.0f - LAM_INIT) / sqrtf(ss * (1.f / 256.f) + NORM_EPS);
                    v4u w; w.x = pk2(o[0] * rs * gv[0], o[1] * rs * gv[1]); w.y = pk2(o[2] * rs * gv[2], o[3] * rs * gv[3]); w.z = pk2(o[4] * rs * gv[4], o[5] * rs * gv[5]); w.w = pk2(o[6] * rs * gv[6], o[7] * rs * gv[7]);
                    *(v4u*)(MIX + row * DM + 2048 + gdh * 256 + 8 * l5) = w; }
            }
        }
#undef get
        if (BOTH(3)) GRID_BAR(3);
    }
    if (IN(5)) {
        pg8::Gemm g{MIX, W_OUT, M, DM, DM}; pg8::StaticOrder S; S.init(M, DM, G, bx);
        pg8::EpiResNorm<false> E{XIN, XN, PS_CROSS, DM, 64};
        pg8::gemm_phase<pg8::EpiResNorm<false>, pg8::StaticOrder, PG8_ALIGN, PG8_SP2>(ldsL + RING_OFF, g, S, E);
        if (BOTH(5)) GRID_BAR(5);
    }
    if (IN(7)) {
        { pg8::StaticOrder S0; S0.init(M, MW, G, bx); pg8::Unit u0; if (S0.next(0, u0)) rs_panel(PS_CROSS, RS_CROSS, u0.pm, tid); VM_WAIT(); __syncthreads(); }
        { pg8::Gemm g{XN, W_MQ, M, MW, DM}; pg8::StaticOrder S; S.init(M, MW, G, bx);
          { LAS float* gt = (LAS float*)(ldsL + EPIX_OFF + 10240); if (tid < 128) gt[tid] = A_IN(20)[tid]; __syncthreads(); }
          pg8::EpiHeads<pg8::PolQc> E{QC, nullptr, RS_CROSS, ldsL + EPIX_OFF};
          pg8::gemm_phase<pg8::EpiHeads<pg8::PolQc>, pg8::StaticOrder, true, PG8_SP2>(ldsL + RING_OFF, g, S, E); }
        { pg8::Gemm g{MEMN, W_MKV, MM, NKV, DM}; pg8::StaticOrder S; S.init(MM, NKV, G, (bx + G - 128) % G);
          { __syncthreads(); LAS float* gt = (LAS float*)(ldsL + EPIX_OFF + 10240); if (tid < 128) gt[tid] = A_IN(21)[tid]; __syncthreads(); }
          pg8::EpiHeads<pg8::PolKv> E{KVC, nullptr, nullptr, ldsL + EPIX_OFF};
          int t2 = threadIdx.x; asm volatile("" : "+v"(t2));
          pg8::gemm_phase<pg8::EpiHeads<pg8::PolKv>, pg8::StaticOrder, true, PG8_SP2>(ldsL + RING_OFF, g, S, E, t2); }
        if (G == 256 && bx >= 160) {
            LAS float* scr = (LAS float*)(ldsL + RING_OFF + wave * 16384);
            for (int it = CV_P0_A + (bx - 160) * NWAVES + wave; it < CV_S_DN; it += 96 * NWAVES) convert_item(it, ws, scr, lane);
        } else if (G != 256 && bx == 0) { LAS float* scr = (LAS float*)(ldsL + RING_OFF + wave * 16384); for (int it = CV_P0_A + wave; it < CV_S_DN; it += NWAVES) convert_item(it, ws, scr, lane); }
        if (BOTH(7)) GRID_BAR(7);
    }
    if (IN(9)) {
        const float mnl_c_ = att_mnl(A_IN(20), A_IN(21), lane);
        for (int I = vcu; I < BATCH * 4 * 8; I += G) {
            const int b = I >> 5, h = (I >> 3) & 3, qb = I & 7;
            att::BlockRef r; const size_t rq = (size_t)b * SEQ + (size_t)qb * 256, rk = (size_t)b * MEML;
            r.Q = QC + ((size_t)(h * BATCH + b) * SEQ + qb * 256) * 128; r.K = KVC + ((size_t)(h * BATCH + b) * MEML) * 128; r.V = KVC + ((size_t)((4 + h) * BATCH + b) * MEML) * 128; r.O = OC + rq * MW + h * 128; r.moba_qb = -1; r.kmi = 0; r.mnl = mnl_c_;
            r.P0 = 1 << 20; r.skv = MEML;
            att::Seam S; att::attn_prime<128, 128, MW, false>(r, (char*)lds + RING_OFF, S); att::attn_block<128, 128, MW, false>(r, r, (char*)lds + RING_OFF, S);
        }
        if (BOTH(9)) GRID_BAR(9);
    }
    if (IN(10)) {
        pg8::Gemm g{OC, W_MO, M, DM, MW}; pg8::StaticOrder S; S.init(M, DM, G, bx);
        pg8::EpiResNorm<true> E{nullptr, XN, PS_FFN, DM, 64};
        pg8::gemm_phase<pg8::EpiResNorm<true>, pg8::StaticOrder, PG8_ALIGN, PG8_SP2>(ldsL + RING_OFF, g, S, E);
        if (BOTH(10)) GRID_BAR(10);
    }
    if (IN(12)) {
        pg8::Gemm g{XN, W_GU, M, NGU, DM}; pg8::StaticOrder S; S.init(M, NGU, G, bx);
        { pg8::Unit u0; int last = -1; for (int i = 0; S.next(i, u0); ++i) if (u0.pm != last) { rs_panel(PS_FFN, RS_FFN, u0.pm, tid); last = u0.pm; } VM_WAIT(); __syncthreads(); }
        pg8::EpiSwiGLU E{HB, FF, RS_FFN};
        pg8::gemm_phase<pg8::EpiSwiGLU, pg8::StaticOrder, PG8_ALIGN, PG8_SP2, PG8_KSPLIT>(ldsL + RING_OFF, g, S, E);
        if (G == 256 && bx >= 128) {
            LAS float* scr = (LAS float*)(ldsL + RING_OFF + wave * 16384);
            for (int it = CV_S_DN + CV_DN_P0 + (bx - 128) * NWAVES + wave; it < CV_NITEMS; it += 128 * NWAVES) convert_item(it, ws, scr, lane);
        } else if (G != 256 && bx == 0) { LAS float* scr = (LAS float*)(ldsL + RING_OFF + wave * 16384); for (int it = CV_S_DN + CV_DN_P0 + wave; it < CV_NITEMS; it += NWAVES) convert_item(it, ws, scr, lane); }
        if (BOTH(12)) GRID_BAR(12);
    }
    if (IN(13)) {
        pg8::Gemm g{HB, W_DN, M, DM, FF}; pg8::StaticOrder S; S.init(M, DM, G, bx);
        pg8::EpiResOut E{XN, OUTW, DM};
        pg8::gemm_phase<pg8::EpiResOut, pg8::StaticOrder, PG8_ALIGN, PG8_SP2>(ldsL + RING_OFF, g, S, E);
    }
#undef IN
#undef BOTH
#undef XIN
#undef OUTR
#undef OUTW
}

extern "C" void kernel_launch(void* const* d_in, const int* in_sizes, int n_in, void* d_out, int out_size, void* d_ws, size_t ws_size, hipStream_t stream) {
    static int grid = 0;
    if (grid == 0) {
        if (n_in != 26 || in_sizes[0] != M * DM || out_size != M * DM || ws_size < WS_END) { fprintf(stderr, "kernel_launch: shape/workspace mismatch (n_in %d, in0 %d, out %d, ws %zu, need %zu)\n", n_in, n_in > 0 ? in_sizes[0] : -1, out_size, ws_size, (size_t)WS_END); grid = -1; return; }
        int dev = 0, cus = 0, per_cu = 0;
        if (hipGetDevice(&dev) != hipSuccess || hipDeviceGetAttribute(&cus, hipDeviceAttributeMultiprocessorCount, dev) != hipSuccess) { grid = -1; return; }
        if (hipFuncSetAttribute((const void*)mk_fwd, hipFuncAttributeMaxDynamicSharedMemorySize, LDS_BYTES) != hipSuccess) { fprintf(stderr, "kernel_launch: hipFuncSetAttribute failed\n"); grid = -1; return; }
        if (hipOccupancyMaxActiveBlocksPerMultiprocessor(&per_cu, (const void*)mk_fwd, NWAVES * 64, LDS_BYTES) != hipSuccess || per_cu < 1)
            fprintf(stderr, "kernel_launch: note: occupancy query reports %d workgroups per CU\n", per_cu);
        (void)hipGetLastError();
        grid = cus;
    }
    if (grid < 0) return;
    if (hipMemsetAsync((char*)d_ws + WS_CTL, 0, CTL_ZERO_BYTES, stream) != hipSuccess) return;
    Args a{};
    for (int i = 0; i < 26; ++i) a.in[i] = (const float*)d_in[i];
    a.out = (float*)d_out; a.outw = (float*)d_out; a.ws = (unsigned char*)d_ws;
    for (int li = 0; li < N_LAUNCHES; ++li) {
        a.ph_lo = (N_LAUNCHES == NPH) ? li : 0; a.ph_hi = (N_LAUNCHES == NPH) ? li + 1 : NPH; a.li = li; a.pad = 0;
        hipLaunchKernelGGL(mk_fwd, dim3(grid), dim3(NWAVES * 64), LDS_BYTES, stream, a);
        const hipError_t le = hipPeekAtLastError();
        if (le != hipSuccess) { fprintf(stderr, "kernel_launch: launch %d failed: %s\n", li, hipGetErrorName(le)); break; }
    }
#if defined(PROBE_LO)
    a.ph_lo = PROBE_LO; a.ph_hi = PROBE_HI; a.li = 1; a.outw = (float*)((char*)d_ws + WS_W_IN);
    hipLaunchKernelGGL(mk_fwd, dim3(grid), dim3(NWAVES * 64), LDS_BYTES, stream, a);
#endif
}
```
